# Optimizing an MI355X kernel written in HIP

```python
import jax, jax.numpy as jnp
from jax import lax
import numpy as np

D_MODEL = 1024
BATCH = 32
SEQ = 256
DEPTH = 4
DEC_BATCH = 4
DEC_SEQ = 2048
PAST_LEN = 512

GRID_W = 64
N_MIXERS = 2
N_ATTN_LAYERS = (DEPTH + 1) // 2
N_POOL_LAYERS = DEPTH // 2
HEAD_DIM = 128
N_HEADS = D_MODEL // HEAD_DIM
N_KV_HEADS = 2
Q_W = N_HEADS * HEAD_DIM
KV_W = N_KV_HEADS * HEAD_DIM
QKV_W = Q_W + 2 * KV_W
ROPE_PAIRS = HEAD_DIM // 4
ROPE_BASE = 10000.0
Q_BLOCK = 128
POOL_WINDOWS = (2, 4, 8, 16)
N_POOL_GROUPS = len(POOL_WINDOWS)
POOL_DG = D_MODEL // N_POOL_GROUPS
D_FF = ((8 * D_MODEL // 3 + 255) // 256) * 256
N_MOD = 6
EPS = 1e-6

kernel_name = "hybrid_attn_pool_diffusion_step"


def rmsnorm(x, g):
    xf = x.astype(jnp.float32)
    y = xf * lax.rsqrt(jnp.mean(xf * xf, axis=-1, keepdims=True) + EPS)
    return (y * g.astype(jnp.float32)).astype(x.dtype)


def modulation(cond, w, b):
    ada = jax.nn.silu(cond) @ w + b
    return ada.reshape(cond.shape[0], 1, N_MOD, D_MODEL)


def modulate(h, shift, scale):
    return h * (1.0 + scale) + shift


def project_qkv(h, w_qkv, qk_g):
    B, T, _ = h.shape
    qkv = h @ w_qkv
    q = qkv[..., :Q_W].reshape(B, T, N_HEADS, HEAD_DIM)
    k = qkv[..., Q_W:Q_W + KV_W].reshape(B, T, N_KV_HEADS, HEAD_DIM)
    v = qkv[..., Q_W + KV_W:].reshape(B, T, N_KV_HEADS, HEAD_DIM)
    return rmsnorm(q, qk_g[0]), rmsnorm(k, qk_g[1]), v


def axial_rope(x):
    B, n, H, _ = x.shape
    rows = n // GRID_W
    row = jnp.broadcast_to(jnp.arange(rows)[:, None], (rows, GRID_W)).reshape(n).astype(jnp.float32)
    col = jnp.broadcast_to(jnp.arange(GRID_W)[None, :], (rows, GRID_W)).reshape(n).astype(jnp.float32)
    inv = ROPE_BASE ** (-jnp.arange(ROPE_PAIRS, dtype=jnp.float32) / ROPE_PAIRS)
    ang = jnp.stack([row[:, None] * inv, col[:, None] * inv], axis=1)
    cos = jnp.cos(ang)[None, :, None]
    sin = jnp.sin(ang)[None, :, None]
    xf = x.astype(jnp.float32).reshape(B, n, H, 2, 2, ROPE_PAIRS)
    x1, x2 = xf[..., 0, :], xf[..., 1, :]
    out = jnp.stack([x1 * cos - x2 * sin, x2 * cos + x1 * sin], axis=-2)
    return out.reshape(x.shape).astype(x.dtype)


def block_attention(q, k, v):
    B, Tq, H, Dh = q.shape
    kvh = k.shape[2]
    G = H // kvh
    nb = Tq // Q_BLOCK
    scale = 1.0 / np.sqrt(Dh)
    kf = k.astype(jnp.float32)
    qb = q.reshape(B, nb, Q_BLOCK, kvh, G, Dh).transpose(1, 0, 2, 3, 4, 5)

    def one_block(qblk):
        s = jnp.einsum('bqkgd,bskd->bkgqs', qblk.astype(jnp.float32), kf) * scale
        p = jax.nn.softmax(s, axis=-1).astype(v.dtype)
        return jnp.einsum('bkgqs,bskd->bqkgd', p, v)

    o = lax.map(one_block, qb)
    return o.transpose(1, 0, 2, 3, 4, 5).reshape(B, Tq, H * Dh)


def multiscale_pool(h, w_pool, pool_scale):
    B, T, D = h.shape
    hf = h.astype(jnp.float32)
    cs = jnp.concatenate([jnp.zeros((B, 1, D), jnp.float32), jnp.cumsum(hf, axis=1)], axis=1)
    t = jnp.arange(T)
    outs = []
    for g, w in enumerate(POOL_WINDOWS):
        lo = jnp.clip(t - w // 2, 0, T)
        hi = jnp.clip(t + w - w // 2, 0, T)
        cnt = (hi - lo).astype(jnp.float32)[None, :, None]
        csg = cs[..., g * POOL_DG:(g + 1) * POOL_DG]
        pooled = (csg[:, hi] - csg[:, lo]) / cnt - hf[..., g * POOL_DG:(g + 1) * POOL_DG]
        outs.append(pooled.astype(h.dtype) @ w_pool[g])
    return jnp.concatenate(outs, axis=-1) * pool_scale


def swiglu(h, w_up, w_down):
    gu = h @ w_up
    return (jax.nn.silu(gu[..., :D_FF]) * gu[..., D_FF:]) @ w_down


def setup_inputs(seed: int = 0) -> dict:
    key = jax.random.key(seed)
    ks = jax.random.split(key, 16)
    f32 = jnp.float32
    nrm = lambda k, s: jax.random.normal(k, s, f32)
    return {
        "x_prompt": nrm(ks[0], (BATCH, SEQ, D_MODEL)),
        "x_sample": nrm(ks[1], (DEC_BATCH, DEC_SEQ, D_MODEL)),
        "c": nrm(ks[2], (DEC_BATCH, D_MODEL)),
        "cache_k": nrm(ks[3], (DEC_BATCH, N_ATTN_LAYERS, PAST_LEN, N_KV_HEADS, HEAD_DIM)),
        "cache_v": nrm(ks[4], (DEC_BATCH, N_ATTN_LAYERS, PAST_LEN, N_KV_HEADS, HEAD_DIM)),
        "c_ctx": nrm(ks[5], (D_MODEL,)),
        "w_ada": nrm(ks[6], (DEPTH, D_MODEL, N_MOD * D_MODEL)) * (0.5 * D_MODEL ** -0.5),
        "b_ada": nrm(ks[7], (DEPTH, N_MOD * D_MODEL)) * 0.02,
        "norm_gains": 1.0 + 0.05 * nrm(ks[8], (DEPTH, 4, D_MODEL)),
        "w_qkv": nrm(ks[9], (N_ATTN_LAYERS, D_MODEL, QKV_W)) * D_MODEL ** -0.5,
        "qk_gains": 1.0 + 0.05 * nrm(ks[10], (N_ATTN_LAYERS, 2, HEAD_DIM)),
        "w_o": nrm(ks[11], (N_ATTN_LAYERS, Q_W, D_MODEL)) * Q_W ** -0.5,
        "w_pool": nrm(ks[12], (N_POOL_LAYERS, N_POOL_GROUPS, POOL_DG, POOL_DG)) * POOL_DG ** -0.5,
        "pool_scale": 0.5 + 0.1 * nrm(ks[13], (N_POOL_LAYERS, D_MODEL)),
        "w_up": nrm(ks[14], (DEPTH, D_MODEL, 2 * D_FF)) * D_MODEL ** -0.5,
        "w_down": nrm(ks[15], (DEPTH, D_FF, D_MODEL)) * D_FF ** -0.5,
    }


def reference(x_prompt, x_sample, c, cache_k, cache_v, c_ctx, w_ada, b_ada, norm_gains,
              w_qkv, qk_gains, w_o, w_pool, pool_scale, w_up, w_down):
    xp = x_prompt
    xs = x_sample
    new_ks = []
    new_vs = []
    for layer in range(DEPTH):
        g = norm_gains[layer]
        mp = modulation(c_ctx[None, :], w_ada[layer], b_ada[layer])
        ms = modulation(c, w_ada[layer], b_ada[layer])
        hp = modulate(rmsnorm(xp, g[0]), mp[:, :, 0], mp[:, :, 1])
        hs = modulate(rmsnorm(xs, g[0]), ms[:, :, 0], ms[:, :, 1])
        if layer % N_MIXERS == 0:
            a = layer // N_MIXERS
            qp, kp, vp = project_qkv(hp, w_qkv[a], qk_gains[a])
            op = block_attention(qp, kp, vp) @ w_o[a]
            new_ks.append(kp)
            new_vs.append(vp)
            qs, ks_, vs_ = project_qkv(hs, w_qkv[a], qk_gains[a])
            qs = axial_rope(qs)
            ks_ = axial_rope(ks_)
            k_all = jnp.concatenate([ks_, cache_k[:, a]], axis=1)
            v_all = jnp.concatenate([vs_, cache_v[:, a]], axis=1)
            os_ = block_attention(qs, k_all, v_all) @ w_o[a]
        else:
            p = layer // N_MIXERS
            op = multiscale_pool(hp, w_pool[p], pool_scale[p])
            os_ = multiscale_pool(hs, w_pool[p], pool_scale[p])
        xp = xp + mp[:, :, 2] * rmsnorm(op, g[1])
        xs = xs + ms[:, :, 2] * rmsnorm(os_, g[1])
        hp = modulate(rmsnorm(xp, g[2]), mp[:, :, 3], mp[:, :, 4])
        hs = modulate(rmsnorm(xs, g[2]), ms[:, :, 3], ms[:, :, 4])
        xp = xp + mp[:, :, 5] * rmsnorm(swiglu(hp, w_up[layer], w_down[layer]), g[3])
        xs = xs + ms[:, :, 5] * rmsnorm(swiglu(hs, w_up[layer], w_down[layer]), g[3])
    new_k = jnp.stack(new_ks, axis=1)
    new_v = jnp.stack(new_vs, axis=1)
    return (xp, xs, new_k, new_v)
```

```cpp
#include <hip/hip_runtime.h>
#include <hip/hip_cooperative_groups.h>
#include <hip/hip_bf16.h>
#include <cstdio>
#include <cstdint>
namespace cg = cooperative_groups;

#define LAS __attribute__((address_space(3)))
typedef unsigned short bf16_t;
typedef short bf16x8 __attribute__((ext_vector_type(8)));
typedef short s16x4 __attribute__((ext_vector_type(4)));
typedef float f32x4 __attribute__((ext_vector_type(4)));
typedef float f32x16 __attribute__((ext_vector_type(16)));
typedef unsigned u32x4 __attribute__((ext_vector_type(4)));
typedef unsigned u32x2 __attribute__((ext_vector_type(2)));

constexpr int DM = 1024, NP = 8192, NS = 8192, NTOK = NP + NS, DFF = 2816, QKVW = 1536, NMODW = 6144;
constexpr int SEQ_P = 256, SEQ_S = 2048, PAST = 512, KV_S = SEQ_S + PAST, KVW = 256;
constexpr float EPS = 1e-6f;
constexpr int NWAVES = 8;

constexpr size_t MiB = 1u << 20;
constexpr size_t WS_WQKV = 1 * MiB;
constexpr size_t WS_WO = 7 * MiB;
constexpr size_t WS_WPOOL = 11 * MiB;
constexpr size_t WS_WUP = 12 * MiB;
constexpr size_t WS_WDN = 56 * MiB;
constexpr size_t WS_MOD = 78 * MiB;
constexpr size_t WS_H = 80 * MiB;
constexpr size_t WS_X16 = 112 * MiB;
constexpr size_t X16_COPY = 32 * MiB;
constexpr size_t WS_MIX = 176 * MiB;
constexpr size_t WS_QKV = WS_MIX;
constexpr size_t WS_KP = WS_MIX + 32 * MiB;
constexpr size_t WS_VP = WS_MIX + 36 * MiB;
constexpr size_t WS_ATTO = WS_MIX + 40 * MiB;
constexpr size_t WS_KS = WS_MIX + 72 * MiB;
constexpr size_t WS_VS = WS_MIX + 82 * MiB;
constexpr size_t WS_ACT = WS_MIX + 92 * MiB;
constexpr size_t KVS_LAYER = 5 * MiB;
constexpr size_t WS_END = WS_MIX + 180 * MiB;

constexpr size_t CTL_ZERO_BYTES = 65536; constexpr int CW_BAR = 4096, CW_SEAM = 8192;
constexpr size_t WS_XB1 = 131072, WS_XB2 = 393216;
constexpr size_t WS_RS = 655360;
constexpr int LDS_BYTES = 147456;

struct Params {
    const float *x_prompt, *x_sample, *c, *cache_k, *cache_v, *c_ctx, *w_ada, *b_ada, *norm_gains, *w_qkv, *qk_gains, *w_o, *w_pool, *pool_scale, *w_up, *w_down;
    float* out; unsigned char* ws;
};

typedef const __attribute__((address_space(4))) Params* KParamsPtr;
__device__ __forceinline__ Params kparams() {
    KParamsPtr q = (KParamsPtr)__builtin_amdgcn_kernarg_segment_ptr(); asm volatile("" : "+s"(q));
    Params p;
    p.x_prompt = q->x_prompt; p.x_sample = q->x_sample; p.c = q->c; p.cache_k = q->cache_k; p.cache_v = q->cache_v; p.c_ctx = q->c_ctx; p.w_ada = q->w_ada; p.b_ada = q->b_ada;
    p.norm_gains = q->norm_gains; p.w_qkv = q->w_qkv; p.qk_gains = q->qk_gains; p.w_o = q->w_o; p.w_pool = q->w_pool; p.pool_scale = q->pool_scale; p.w_up = q->w_up; p.w_down = q->w_down;
    p.out = q->out; p.ws = q->ws;
    return p;
}

__device__ __forceinline__ unsigned cvt_pk_bf16(float lo, float hi) { unsigned r; asm volatile("v_cvt_pk_bf16_f32 %0, %1, %2" : "=v"(r) : "v"(lo), "v"(hi)); return r; }
__device__ __forceinline__ float bf_lo(unsigned u) { return __uint_as_float(u << 16); }
__device__ __forceinline__ float bf_hi(unsigned u) { return __uint_as_float(u & 0xffff0000u); }

__device__ __forceinline__ float sum_xor16(float v) { auto r = __builtin_amdgcn_permlane16_swap(__float_as_uint(v), __float_as_uint(v), false, false); return __uint_as_float(r[0]) + __uint_as_float(r[1]); }
__device__ __forceinline__ float sum_xor32(float v) { auto r = __builtin_amdgcn_permlane32_swap(__float_as_uint(v), __float_as_uint(v), false, false); return __uint_as_float(r[0]) + __uint_as_float(r[1]); }
template <int CTRL> __device__ __forceinline__ float dpp_f(float v) { return __uint_as_float((unsigned)__builtin_amdgcn_update_dpp(0, (int)__float_as_uint(v), CTRL, 0xf, 0xf, true)); }
__device__ __forceinline__ float row16_sum(float v) { v += dpp_f<0x128>(v); v += dpp_f<0x124>(v); v += dpp_f<0x122>(v); v += dpp_f<0x121>(v); return v; }
__device__ __forceinline__ float wave_sum(float v) { return sum_xor32(sum_xor16(row16_sum(v))); }
__device__ __forceinline__ int opaque_tid() { int t = threadIdx.x; asm volatile("" : "+v"(t)); return t; }
__device__ __forceinline__ int vcu();
__device__ __forceinline__ float silu_f(float x) { return x / (1.0f + __expf(-x)); }

namespace pg8 {
constexpr int BM = 256, BK = 64, HALF = 128, HTB = HALF * BK * 2, STAGE_BYTES = 8 * HTB, NXCD = 8, WGM = 8;
__host__ __device__ __forceinline__ int lds_byte(int r, int c) { const int st = (r >> 4) * 2 + (c >> 5), rr = r & 15, cc = c & 31, ob = rr * 64 + cc * 2; return st * 1024 + (ob ^ (((ob >> 9) & 1) << 5)); }
__host__ __device__ __forceinline__ void stage_rc(int b, int& R, int& C) { const int st = b / 1024, sb = b % 1024, swz = sb ^ (((sb >> 9) & 1) << 5); R = (st >> 1) * 16 + swz / 64; C = (st & 1) * 32 + (swz % 64) / 2; }
__host__ __device__ __forceinline__ int perm32(int rho) { const int n = rho >> 4, i = rho & 15; return 8 * (i >> 2) + 4 * n + (i & 3); }

struct Unit { int pm, pn; };
struct Gemm { const bf16_t* A; const bf16_t* Bt; int M, N, K; int lda; int acol; };

struct StaticOrder {
    int nM, nN, nwg, G, c;
    __device__ void init(int M, int N, int G_, int c_) { nM = M / BM; nN = N / BM; nwg = nM * nN; G = G_; c = c_; }
    __device__ bool next(int i, Unit& u) const {
        const long L = (long)i * G + c; if (L >= nwg) return false;
        int wgid = (int)L; { const int q = nwg / NXCD, r = nwg % NXCD, xcd = wgid % NXCD, off = wgid / NXCD; wgid = (xcd < r ? xcd * (q + 1) : r * (q + 1) + (xcd - r) * q) + off; }
        const int nig = WGM * nN, gid = wgid / nig, fm = gid * WGM, gsz = (nM - fm) < WGM ? (nM - fm) : WGM;
        u.pm = fm + ((wgid % nig) % gsz); u.pn = (wgid % nig) / gsz; return true;
    }
};

struct EpiBf16 {
    static constexpr bool PERM = true, AFTER_DRAIN = false;
    bf16_t* O; int ldc;
    __device__ __forceinline__ void operator()(const f32x4 (&acc)[2][2][4][2], const Unit& u, int wr, int wc, int fr, int fq, LAS unsigned char* lds) const {
        const int row0 = u.pm * BM + wr * 64 + fr; const int col0 = u.pn * BM + wc * 32 + 8 * fq;
#pragma unroll
        for (int ai = 0; ai < 2; ++ai)
#pragma unroll
            for (int m = 0; m < 4; ++m) { bf16_t* rowp = O + (size_t)(row0 + ai * HALF + m * 16) * ldc + col0;
#pragma unroll
                for (int bj = 0; bj < 2; ++bj) { const f32x4 v0 = acc[ai][bj][m][0], v1 = acc[ai][bj][m][1];
                    u32x4 w; w.x = cvt_pk_bf16(v0[0], v0[1]); w.y = cvt_pk_bf16(v0[2], v0[3]); w.z = cvt_pk_bf16(v1[0], v1[1]); w.w = cvt_pk_bf16(v1[2], v1[3]);
                    *(u32x4*)(rowp + bj * HALF) = w; } }
    }
};

template <int KIND, bool SMP>
__device__ __forceinline__ void qkv_body(const f32x4 (&acc)[2][2][4][2], const LAS float* XS, bf16_t* dst, int dstride, float* onew, int rl0, int ntok0, int a, f32x4 g1, f32x4 g2, f32x4 inv) {
#pragma unroll
    for (int ai = 0; ai < 2; ++ai)
#pragma unroll
        for (int m = 0; m < 4; ++m) { const int rl = ai * HALF + rl0 + m * 16;
            f32x4 cs, sn;
            if (SMP && KIND < 2) { const int ntok = ntok0 + rl; const float pos = (float)(a == 0 ? (ntok >> 6) : (ntok & 63));
#pragma unroll
                for (int j = 0; j < 4; ++j) { const float rev = __builtin_amdgcn_fractf(pos * inv[j]); sn[j] = __builtin_amdgcn_sinf(rev); cs[j] = __builtin_amdgcn_cosf(rev); } }
#pragma unroll
            for (int bj = 0; bj < 2; ++bj) { f32x4 o1 = acc[ai][bj][m][0], o2 = acc[ai][bj][m][1];
                if (KIND < 2) { const f32x4 ps = *(const LAS f32x4*)(XS + (rl * 2 + bj) * 4); const float rs = __builtin_amdgcn_rsqf(((ps[0] + ps[1]) + (ps[2] + ps[3])) * (1.0f / 128.0f) + 1e-6f);
                    const f32x4 y1 = o1 * rs * g1, y2 = o2 * rs * g2;
                    if (SMP) { o1 = y1 * cs - y2 * sn; o2 = y2 * cs + y1 * sn; } else { o1 = y1; o2 = y2; } }
                u32x2 w1, w2; w1.x = cvt_pk_bf16(o1[0], o1[1]); w1.y = cvt_pk_bf16(o1[2], o1[3]); w2.x = cvt_pk_bf16(o2[0], o2[1]); w2.y = cvt_pk_bf16(o2[2], o2[3]);
                bf16_t* d = dst + rl * dstride + bj * 128; *(u32x2*)d = w1; *(u32x2*)(d + 32) = w2;
                if (KIND > 0 && !SMP) { float* o = onew + rl * 256 + bj * 128; *(f32x4*)o = o1; *(f32x4*)(o + 32) = o2; }
            }
            asm volatile("" ::: "memory"); __builtin_amdgcn_sched_barrier(0);
        }
}
struct EpiQKV {
    static constexpr bool PERM = true, AFTER_DRAIN = false;
    int al;
    __device__ __forceinline__ void operator()(const f32x4 (&acc)[2][2][4][2], const Unit& u, int wr, int wc, int fr, int fq, LAS unsigned char* lds) const {
        const Params kp = kparams();
        LAS float* XS = (LAS float*)(lds + STAGE_BYTES);
        const int pn = u.pn, rowt = u.pm * BM, rl0 = wr * 64 + fr;
        if (pn < 5) {
#pragma unroll
            for (int ai = 0; ai < 2; ++ai)
#pragma unroll
                for (int m = 0; m < 4; ++m)
#pragma unroll
                    for (int bj = 0; bj < 2; ++bj) { const f32x4 a0 = acc[ai][bj][m][0], a1 = acc[ai][bj][m][1];
                        float s = ((a0[0] * a0[0] + a0[1] * a0[1]) + (a0[2] * a0[2] + a0[3] * a0[3])) + ((a1[0] * a1[0] + a1[1] * a1[1]) + (a1[2] * a1[2] + a1[3] * a1[3]));
                        s = sum_xor32(sum_xor16(s));
                        if (fq == 0) XS[((ai * HALF + rl0 + m * 16) * 2 + bj) * 4 + wc] = s; }
        }
        asm volatile("s_waitcnt lgkmcnt(0)" ::: "memory"); __builtin_amdgcn_s_barrier(); asm volatile("" ::: "memory");
        const bool smp = rowt >= 8192;
        const int a = wc >> 1, pp0 = 16 * (wc & 1) + 4 * fq, d0 = 64 * a + pp0;
        f32x4 g1 = (f32x4){1.f, 1.f, 1.f, 1.f}, g2 = g1, inv = g1;
        if (pn < 5) { const float* gq = kp.qk_gains + (size_t)(al * 2 + (pn < 4 ? 0 : 1)) * 128; g1 = *(const f32x4*)(gq + d0); g2 = *(const f32x4*)(gq + d0 + 32);
#pragma unroll
            for (int j = 0; j < 4; ++j) inv[j] = __builtin_amdgcn_exp2f(-(float)(pp0 + j) * (13.287712379549449f / 32.0f)) * 0.15915494309189535f; }
        const int ntok0 = (rowt - 8192) & 2047, bs = (rowt - 8192) >> 11;
        if (pn < 4) { bf16_t* dst = (bf16_t*)(kp.ws + WS_QKV) + (size_t)rowt * 1024 + 2 * pn * 128 + d0;
            if (smp) qkv_body<0, true>(acc, XS, dst, 1024, nullptr, rl0, ntok0, a, g1, g2, inv); else qkv_body<0, false>(acc, XS, dst, 1024, nullptr, rl0, ntok0, a, g1, g2, inv); }
        else { const bool isv = pn == 5;
            bf16_t* dst = smp ? (bf16_t*)(kp.ws + (isv ? WS_VS : WS_KS) + (size_t)al * KVS_LAYER) + ((size_t)bs * 2560 + ntok0) * 256 + d0 : (bf16_t*)(kp.ws + (isv ? WS_VP : WS_KP)) + (size_t)rowt * 256 + d0;
            float* onew = kp.out + (size_t)16384 * 1024 + (isv ? (size_t)32 * 2 * 256 * 256 : 0) + (size_t)((rowt >> 8) * 2 + al) * 65536 + d0;
            if (!isv) { if (smp) qkv_body<1, true>(acc, XS, dst, 256, onew, rl0, ntok0, a, g1, g2, inv); else qkv_body<1, false>(acc, XS, dst, 256, onew, rl0, ntok0, a, g1, g2, inv); }
            else { if (smp) qkv_body<2, true>(acc, XS, dst, 256, onew, rl0, ntok0, a, g1, g2, inv); else qkv_body<2, false>(acc, XS, dst, 256, onew, rl0, ntok0, a, g1, g2, inv); } }
    }
};
struct EpiSwiGLU {
    static constexpr bool PERM = true, AFTER_DRAIN = false;
    bf16_t* O;
    __device__ __forceinline__ void operator()(const f32x4 (&acc)[2][2][4][2], const Unit& u, int wr, int wc, int fr, int fq, LAS unsigned char* lds) const {
        const int row0 = u.pm * BM + wr * 64 + fr; const int col0 = u.pn * 128 + wc * 16 + 4 * fq;
#pragma unroll
        for (int ai = 0; ai < 2; ++ai)
#pragma unroll
            for (int m = 0; m < 4; ++m) { bf16_t* rowp = O + (size_t)(row0 + ai * HALF + m * 16) * DFF + col0;
#pragma unroll
                for (int bj = 0; bj < 2; ++bj) { const f32x4 g = acc[ai][bj][m][0], up = acc[ai][bj][m][1]; f32x4 v;
#pragma unroll
                    for (int j = 0; j < 4; ++j) v[j] = g[j] * __builtin_amdgcn_rcpf(1.0f + __builtin_amdgcn_exp2f(-1.4426950408889634f * g[j])) * up[j];
                    u32x2 w; w.x = cvt_pk_bf16(v[0], v[1]); w.y = cvt_pk_bf16(v[2], v[3]);
                    *(u32x2*)(rowp + bj * 64) = w; } }
    }
};
struct EpiF32 {
    static constexpr bool PERM = false, AFTER_DRAIN = false;
    float* O; int ldc; const float* colscale;
    __device__ __forceinline__ void operator()(const f32x4 (&acc)[2][2][4][2], const Unit& u, int wr, int wc, int fr, int fq, LAS unsigned char* lds) const {
        const int row0 = u.pm * BM + wr * 64 + fr; const int col0 = u.pn * BM + wc * 32 + 4 * fq;
#pragma unroll
        for (int bj = 0; bj < 2; ++bj)
#pragma unroll
            for (int n = 0; n < 2; ++n) { const int col = col0 + bj * HALF + n * 16;
                const f32x4 sc = colscale ? *(const f32x4*)(colscale + col) : (f32x4){1.f, 1.f, 1.f, 1.f};
#pragma unroll
                for (int ai = 0; ai < 2; ++ai)
#pragma unroll
                    for (int m = 0; m < 4; ++m) *(f32x4*)(O + (size_t)(row0 + ai * HALF + m * 16) * ldc + col) = acc[ai][bj][m][n] * sc; }
    }
};

struct PanelSS {
    float* xbuf;
    unsigned* cnt;
    unsigned want;
    __device__ __forceinline__ void run(const float (&part)[2][4], const Unit& u, int wr, int wc, int fr, int fq, LAS unsigned char* lds, int wid, int lane) const {
        LAS float* P = (LAS float*)lds;
        LAS float* S = (LAS float*)(lds + 4096);
#pragma unroll
        for (int ai = 0; ai < 2; ++ai)
#pragma unroll
            for (int m = 0; m < 4; ++m) { float s = part[ai][m]; s = sum_xor32(sum_xor16(s));
                if (fq == 0) P[(ai * HALF + wr * 64 + m * 16 + fr) * 4 + wc] = s; }
        asm volatile("s_waitcnt lgkmcnt(0)" ::: "memory"); __builtin_amdgcn_s_barrier(); asm volatile("" ::: "memory");
        const int row = wid * 32 + (lane & 31);
        if (lane < 32) { const float t = (P[row * 4 + 0] + P[row * 4 + 1]) + (P[row * 4 + 2] + P[row * 4 + 3]);
            __hip_atomic_store(xbuf + (size_t)(u.pm * BM + row) * 4 + u.pn, t, __ATOMIC_RELAXED, __HIP_MEMORY_SCOPE_AGENT); }
        asm volatile("s_waitcnt vmcnt(0)" ::: "memory");
        if (lane == 0) __hip_atomic_fetch_add(cnt + 64 * u.pm, 1u, __ATOMIC_RELAXED, __HIP_MEMORY_SCOPE_AGENT);
        if (wid == 0) {
            unsigned sp = 0;
            for (;;) {
                if ((unsigned)__builtin_amdgcn_readfirstlane(__hip_atomic_load(cnt + 64 * u.pm, __ATOMIC_RELAXED, __HIP_MEMORY_SCOPE_AGENT)) >= want) break;
                if (++sp > (1u << 22)) break;
                __builtin_amdgcn_s_sleep(2);
            }
            __builtin_amdgcn_fence(__ATOMIC_ACQUIRE, "agent");
        }
        asm volatile("s_waitcnt vmcnt(0) lgkmcnt(0)" ::: "memory"); __builtin_amdgcn_s_barrier(); asm volatile("" ::: "memory");
        if (lane < 32) { const float* slot = xbuf + (size_t)(u.pm * BM + row) * 4; float t = 0.f;
#pragma unroll
            for (int q = 0; q < 4; ++q) t += __hip_atomic_load(slot + q, __ATOMIC_RELAXED, __HIP_MEMORY_SCOPE_AGENT);
            S[row] = __builtin_amdgcn_rsqf(t * (1.0f / 1024.0f) + 1e-6f); }
        asm volatile("s_waitcnt lgkmcnt(0)" ::: "memory"); __builtin_amdgcn_s_barrier(); asm volatile("" ::: "memory");
    }
};
struct EpiFused {
    static constexpr bool PERM = true, AFTER_DRAIN = true;
    int l, stage; unsigned want;
    __device__ __forceinline__ void fused(f32x4 (&acc)[2][2][4][2], const Unit& u, int wr, int wc, int fr, int fq, LAS unsigned char* lds, int wid, int lane) const {
        const Params kp = kparams();
        const unsigned kf = want / 32u - 1u, rb = (kf >= 3u && kf <= 6u) ? 1u : 0u, wb = (kf >= 2u && kf <= 5u) ? 1u : 0u;
        const bf16_t* X16 = (const bf16_t*)(kp.ws + WS_X16 + rb * X16_COPY); bf16_t* X16w = (bf16_t*)(kp.ws + WS_X16 + wb * X16_COPY); const float* mod = (const float*)(kp.ws + WS_MOD);
        const float* colscale = (stage == 0 && (l & 1)) ? kp.pool_scale + (size_t)(l >> 1) * 1024 : nullptr;
        const int ln = stage == 0 ? l : (l < 3 ? l + 1 : 3);
        const float* modg = mod + (size_t)l * 5 * 6144; const int gate_idx = stage == 0 ? 2 : 5; const float* g_post = kp.norm_gains + (size_t)(l * 4 + (stage == 0 ? 1 : 3)) * 1024;
        const float* modh = mod + (size_t)ln * 5 * 6144; const int shift_idx = stage == 0 ? 3 : 0; const float* g_pre = kp.norm_gains + (size_t)(ln * 4 + (stage == 0 ? 2 : 0)) * 1024;
        const bool last = (stage == 1 && l == 3);
        const PanelSS st1{(float*)(kp.ws + WS_XB1), (unsigned*)kp.ws + CW_SEAM, want}, st2{(float*)(kp.ws + WS_XB2), (unsigned*)kp.ws + CW_SEAM + 4096, want};
        const LAS float* S = (const LAS float*)(lds + 4096);
        const int col0 = u.pn * BM + wc * 32 + 8 * fq, rowt = u.pm * BM;
        const int cond = rowt < 8192 ? 0 : 1 + ((rowt - 8192) >> 11);
        u32x4 pre[2][4][2];
#pragma unroll
        for (int m = 0; m < 4; ++m) { const bf16_t* xr = X16 + (size_t)(rowt + wr * 64 + m * 16 + fr) * 1024 + col0;
#pragma unroll
            for (int bj = 0; bj < 2; ++bj) pre[0][m][bj] = *(const u32x4*)(xr + bj * HALF); }
        if (colscale) {
#pragma unroll
            for (int bj = 0; bj < 2; ++bj)
#pragma unroll
                for (int n = 0; n < 2; ++n) { const f32x4 sc = *(const f32x4*)(colscale + col0 + bj * HALF + n * 4);
#pragma unroll
                    for (int ai = 0; ai < 2; ++ai)
#pragma unroll
                        for (int m = 0; m < 4; ++m) acc[ai][bj][m][n] *= sc; }
        }
        float part[2][4];
#pragma unroll
        for (int ai = 0; ai < 2; ++ai)
#pragma unroll
            for (int m = 0; m < 4; ++m) { float s = 0.f;
#pragma unroll
                for (int bj = 0; bj < 2; ++bj)
#pragma unroll
                    for (int n = 0; n < 2; ++n) { const f32x4 v = acc[ai][bj][m][n]; s += (v[0] * v[0] + v[1] * v[1]) + (v[2] * v[2] + v[3] * v[3]); }
                part[ai][m] = s; }
        st1.run(part, u, wr, wc, fr, fq, lds, wid, lane);
#pragma unroll
        for (int m = 0; m < 4; ++m) { const bf16_t* xr = X16 + (size_t)(rowt + HALF + wr * 64 + m * 16 + fr) * 1024 + col0;
#pragma unroll
            for (int bj = 0; bj < 2; ++bj) pre[1][m][bj] = *(const u32x4*)(xr + bj * HALF); }
        {
            f32x4 Gv[2][2];
#pragma unroll
            for (int bj = 0; bj < 2; ++bj)
#pragma unroll
                for (int n = 0; n < 2; ++n) { const int col = col0 + bj * HALF + n * 4;
                    Gv[bj][n] = *(const f32x4*)(modg + (size_t)cond * 6144 + gate_idx * 1024 + col) * *(const f32x4*)(g_post + col); }
#pragma unroll
            for (int ai = 0; ai < 2; ++ai)
#pragma unroll
                for (int m = 0; m < 4; ++m) { const float rs = S[ai * HALF + wr * 64 + m * 16 + fr];
#pragma unroll
                    for (int bj = 0; bj < 2; ++bj) { const u32x4 xp = pre[ai][m][bj];
                        const f32x4 xv0 = (f32x4){bf_lo(xp.x), bf_hi(xp.x), bf_lo(xp.y), bf_hi(xp.y)}, xv1 = (f32x4){bf_lo(xp.z), bf_hi(xp.z), bf_lo(xp.w), bf_hi(xp.w)};
                        acc[ai][bj][m][0] = xv0 + Gv[bj][0] * (acc[ai][bj][m][0] * rs); acc[ai][bj][m][1] = xv1 + Gv[bj][1] * (acc[ai][bj][m][1] * rs); } }
        }
        if (!last) {
#pragma unroll
            for (int ai = 0; ai < 2; ++ai)
#pragma unroll
                for (int m = 0; m < 4; ++m) { float s = 0.f;
#pragma unroll
                    for (int bj = 0; bj < 2; ++bj)
#pragma unroll
                        for (int n = 0; n < 2; ++n) { const f32x4 v = acc[ai][bj][m][n]; s += (v[0] * v[0] + v[1] * v[1]) + (v[2] * v[2] + v[3] * v[3]); }
                    part[ai][m] = s; }
            st2.run(part, u, wr, wc, fr, fq, lds, wid, lane);
            asm volatile("" : "+v"(fr), "+v"(fq));
            const int col0 = u.pn * BM + wc * 32 + 8 * fq;
            if (stage == 1 && (l & 1) == 0 && gridDim.x == 256) {
                if (u.pn == 0 && lane < 32) ((float*)(kp.ws + WS_RS))[rowt + wid * 32 + lane] = S[wid * 32 + lane];
#pragma unroll
                for (int ai = 0; ai < 2; ++ai)
#pragma unroll
                    for (int m = 0; m < 4; ++m) { const size_t off = (size_t)(rowt + ai * HALF + wr * 64 + m * 16 + fr) * 1024 + col0;
#pragma unroll
                        for (int bj = 0; bj < 2; ++bj) { const f32x4 x0 = acc[ai][bj][m][0], x1 = acc[ai][bj][m][1];
                            u32x4 xw; xw.x = cvt_pk_bf16(x0[0], x0[1]); xw.y = cvt_pk_bf16(x0[2], x0[3]); xw.z = cvt_pk_bf16(x1[0], x1[1]); xw.w = cvt_pk_bf16(x1[2], x1[3]);
                            *(u32x4*)(X16w + off + bj * HALF) = xw; } }
                return;
            }
            bf16_t* H = (bf16_t*)(kp.ws + WS_H);
            f32x4 Av[2][2], Bv[2][2];
#pragma unroll
            for (int bj = 0; bj < 2; ++bj)
#pragma unroll
                for (int n = 0; n < 2; ++n) { const int col = col0 + bj * HALF + n * 4;
                    Av[bj][n] = *(const f32x4*)(g_pre + col) * (*(const f32x4*)(modh + (size_t)cond * 6144 + (shift_idx + 1) * 1024 + col) + 1.0f);
                    Bv[bj][n] = *(const f32x4*)(modh + (size_t)cond * 6144 + shift_idx * 1024 + col); }
#pragma unroll
            for (int ai = 0; ai < 2; ++ai)
#pragma unroll
                for (int m = 0; m < 4; ++m) { const int r = ai * HALF + wr * 64 + m * 16 + fr; const float rs = S[r]; const size_t off = (size_t)(rowt + r) * 1024 + col0;
#pragma unroll
                    for (int bj = 0; bj < 2; ++bj) { const f32x4 x0 = acc[ai][bj][m][0], x1 = acc[ai][bj][m][1];
                        u32x4 xw; xw.x = cvt_pk_bf16(x0[0], x0[1]); xw.y = cvt_pk_bf16(x0[2], x0[3]); xw.z = cvt_pk_bf16(x1[0], x1[1]); xw.w = cvt_pk_bf16(x1[2], x1[3]);
                        *(u32x4*)(X16w + off + bj * HALF) = xw;
                        const f32x4 h0 = (x0 * rs) * Av[bj][0] + Bv[bj][0], h1 = (x1 * rs) * Av[bj][1] + Bv[bj][1];
                        u32x4 w; w.x = cvt_pk_bf16(h0[0], h0[1]); w.y = cvt_pk_bf16(h0[2], h0[3]); w.z = cvt_pk_bf16(h1[0], h1[1]); w.w = cvt_pk_bf16(h1[2], h1[3]);
                        *(u32x4*)(H + off + bj * HALF) = w; }
                    asm volatile("" ::: "memory"); }
        } else {
            float* X = kp.out;
#pragma unroll
            for (int ai = 0; ai < 2; ++ai)
#pragma unroll
                for (int m = 0; m < 4; ++m) { const size_t off = (size_t)(rowt + ai * HALF + wr * 64 + m * 16 + fr) * 1024 + col0;
#pragma unroll
                    for (int bj = 0; bj < 2; ++bj)
#pragma unroll
                        for (int n = 0; n < 2; ++n) *(f32x4*)(X + off + bj * HALF + n * 4) = acc[ai][bj][m][n]; }
        }
    }
};

template <class Epi, class Sched, bool ALIGN_EPI>
__device__ __forceinline__ void gemm_phase(LAS unsigned char* lds, const Gemm g, const Sched& S, const Epi& E) {
    const int tid = opaque_tid(), wid = __builtin_amdgcn_readfirstlane(tid >> 6), lane = tid & 63, wr = wid >> 2, wc = wid & 3, fr = lane & 15, fq = lane >> 4;
    const int K = g.K, nt = K / BK, lda = g.lda;
    unsigned voffA[2], voffB[2];
#pragma unroll
    for (int i = 0; i < 2; ++i) { int R, C; stage_rc(tid * 16 + i * 8192, R, C); const int Rb = Epi::PERM ? ((R & ~31) + perm32(R & 31)) : R;
        voffA[i] = (unsigned)(R * lda + C) * 2u; voffB[i] = (unsigned)(Rb * K + C) * 2u; }
    const size_t kstep = (size_t)(BK * 2);
    const size_t hA = (size_t)HALF * lda * 2, hB = (size_t)HALF * K * 2;
    const size_t tA = 2 * hA, tB = 2 * hB;
    const size_t acolB = (size_t)g.acol * 2;
    const unsigned ldsw = (unsigned)wid * 1024u;
    const int aoff = lds_byte(wr * 64 + fr, fq * 8), boff = lds_byte(wc * 32 + fr, fq * 8);
#define PG8_SA(b, h) (((b) * 2 + (h)) * HTB)
#define PG8_SB(b, h) ((4 + (b) * 2 + (h)) * HTB)
#define PG8_STAGE(bufoff, gbase, voff) do { _Pragma("unroll") for (int _i = 0; _i < 2; ++_i) \
        __builtin_amdgcn_global_load_lds((const unsigned*)((const char*)(gbase) + (voff)[_i]), (LAS unsigned*)(lds + (bufoff) + ldsw + _i * 8192), 16, 0, 0); } while (0)
#define PG8_LDA(dst, b, h) do { _Pragma("unroll") for (int m = 0; m < 4; ++m) _Pragma("unroll") for (int k = 0; k < 2; ++k) dst[m][k] = *(const LAS bf16x8*)(lds + PG8_SA(b, h) + aoff + m * 2048 + k * 1024); } while (0)
#define PG8_LDB(dst, b, h) do { _Pragma("unroll") for (int n = 0; n < 2; ++n) _Pragma("unroll") for (int k = 0; k < 2; ++k) dst[n][k] = *(const LAS bf16x8*)(lds + PG8_SB(b, h) + boff + n * 2048 + k * 1024); } while (0)
#define PG8_MMA(ai, bj, At, Bt) do { __builtin_amdgcn_s_setprio(1); _Pragma("unroll") for (int m = 0; m < 4; ++m) _Pragma("unroll") for (int n = 0; n < 2; ++n) _Pragma("unroll") for (int k = 0; k < 2; ++k) \
        acc[ai][bj][m][n] = __builtin_amdgcn_mfma_f32_16x16x32_bf16(Bt[n][k], At[m][k], acc[ai][bj][m][n], 0, 0, 0); __builtin_amdgcn_s_setprio(0); } while (0)
#define PG8_WAIT_V(n) asm volatile("s_waitcnt vmcnt(" #n ")" ::: "memory")
#define PG8_WAIT_L(n) asm volatile("s_waitcnt lgkmcnt(" #n ")" ::: "memory")
#define PG8_BAR __builtin_amdgcn_s_barrier()
#define PG8_SCHED __builtin_amdgcn_sched_barrier(0)
    Unit cur, nxt; int ui = 0;
    if (!S.next(0, cur)) return;
    f32x4 acc[2][2][4][2];
#pragma unroll
    for (int a = 0; a < 2; ++a)
#pragma unroll
        for (int b = 0; b < 2; ++b)
#pragma unroll
            for (int m = 0; m < 4; ++m)
#pragma unroll
                for (int n = 0; n < 2; ++n) acc[a][b][m][n] = (f32x4){0.f, 0.f, 0.f, 0.f};
    bf16x8 At[4][2], B0[2][2], B1[2][2];
    const char* cA = (const char*)g.A + (size_t)cur.pm * tA + (size_t)cur.pn * acolB; const char* cB = (const char*)g.Bt + (size_t)cur.pn * tB;
    PG8_STAGE(PG8_SB(0, 0), cB, voffB); PG8_STAGE(PG8_SB(0, 1), cB + hB, voffB); PG8_STAGE(PG8_SA(0, 0), cA, voffA); PG8_STAGE(PG8_SA(0, 1), cA + hA, voffA);
    if (wr == 1) PG8_BAR;
    PG8_WAIT_V(2); PG8_BAR;
    PG8_STAGE(PG8_SB(1, 0), cB + kstep, voffB); PG8_STAGE(PG8_SA(1, 0), cA + kstep, voffA); PG8_STAGE(PG8_SB(1, 1), cB + hB + kstep, voffB);
    PG8_WAIT_V(6); PG8_BAR;
    for (;;) {
        const bool has_next = S.next(ui + 1, nxt);
        const char* nA = has_next ? (const char*)g.A + (size_t)nxt.pm * tA + (size_t)nxt.pn * acolB : cA; const char* nB = has_next ? (const char*)g.Bt + (size_t)nxt.pn * tB : cB;
        for (int t = 0; t < nt; t += 2) {
            const bool last = (t == nt - 2);
            const char* a1 = cA + (size_t)(t + 1) * kstep;
            const char* a2 = last ? nA : cA + (size_t)(t + 2) * kstep; const char* b2 = last ? nB : cB + (size_t)(t + 2) * kstep;
            const char* a3 = a2 + kstep; const char* b3 = b2 + kstep;
            PG8_LDB(B0, 0, 0); PG8_LDB(B1, 0, 1); PG8_SCHED; PG8_LDA(At, 0, 0); PG8_STAGE(PG8_SA(1, 1), a1 + hA, voffA);
            PG8_WAIT_V(8); PG8_WAIT_L(0); PG8_BAR; PG8_MMA(0, 0, At, B0); PG8_MMA(0, 1, At, B1); PG8_BAR; PG8_SCHED;
            PG8_LDA(At, 0, 1); PG8_STAGE(PG8_SB(0, 0), b2, voffB); PG8_STAGE(PG8_SB(0, 1), b2 + hB, voffB); PG8_STAGE(PG8_SA(0, 0), a2, voffA);
            PG8_WAIT_V(8); PG8_WAIT_L(0); PG8_BAR; PG8_MMA(1, 0, At, B0); PG8_MMA(1, 1, At, B1); PG8_BAR; PG8_SCHED;
            PG8_LDB(B0, 1, 0); PG8_LDB(B1, 1, 1); PG8_SCHED; PG8_LDA(At, 1, 0); PG8_STAGE(PG8_SA(0, 1), a2 + hA, voffA);
            PG8_WAIT_V(8); PG8_WAIT_L(0); PG8_BAR; PG8_MMA(0, 0, At, B0); PG8_MMA(0, 1, At, B1); PG8_BAR; PG8_SCHED;
            PG8_LDA(At, 1, 1); PG8_STAGE(PG8_SB(1, 0), b3, voffB); PG8_STAGE(PG8_SB(1, 1), b3 + hB, voffB); PG8_STAGE(PG8_SA(1, 0), a3, voffA);
            PG8_WAIT_V(8); PG8_WAIT_L(0); PG8_BAR; PG8_MMA(1, 0, At, B0); PG8_MMA(1, 1, At, B1); PG8_BAR; PG8_SCHED;
        }
        if constexpr (ALIGN_EPI) { if (wr == 0) PG8_BAR; }
        if constexpr (!Epi::AFTER_DRAIN) { int fr_ = fr, fq_ = fq, wr_ = wr, wc_ = wc; asm volatile("" : "+v"(fr_), "+v"(fq_), "+s"(wr_), "+s"(wc_)); E(acc, cur, wr_, wc_, fr_, fq_, lds); }
        if (!has_next) break;
#pragma unroll
        for (int a = 0; a < 2; ++a)
#pragma unroll
            for (int b = 0; b < 2; ++b)
#pragma unroll
                for (int m = 0; m < 4; ++m)
#pragma unroll
                    for (int n = 0; n < 2; ++n) acc[a][b][m][n] = (f32x4){0.f, 0.f, 0.f, 0.f};
        cur = nxt; cA = nA; cB = nB; ++ui;
        if constexpr (ALIGN_EPI) { if (wr == 1) PG8_BAR; }
    }
    PG8_WAIT_V(0);
    if constexpr (!ALIGN_EPI) { if (wr == 0) PG8_BAR; }
    PG8_BAR;
    if constexpr (Epi::AFTER_DRAIN) { int fr_ = fr, fq_ = fq, wr_ = wr, wc_ = wc; asm volatile("" : "+v"(fr_), "+v"(fq_), "+s"(wr_), "+s"(wc_)); E.fused(acc, cur, wr_, wc_, fr_, fq_, lds, wid, lane); }
#undef PG8_SA
#undef PG8_SB
#undef PG8_STAGE
#undef PG8_LDA
#undef PG8_LDB
#undef PG8_MMA
#undef PG8_WAIT_V
#undef PG8_WAIT_L
#undef PG8_BAR
#undef PG8_SCHED
}
}

namespace attn {
constexpr int D = 128, NW = 8, QBLK = 32, KVBLK = 64;
constexpr float SCALE = 0.088388347648318440f;
constexpr float THR = 8.f;
constexpr int LDQ = DM, LDK = KVW, LDO = DM;
constexpr size_t SHM_V = KVBLK * D * 2, SHM_K = KVBLK * D * 2, SHM_ATTN = 2 * SHM_V + 2 * SHM_K + NW * 64 * 4;
#define KSWZ(row, colB) ((row) * 256 + ((colB) ^ (((row) & 7) << 4)))
#define SBAR() __builtin_amdgcn_sched_barrier(0)
__device__ __forceinline__ int crow(int r, int hi) { return (r & 3) + 8 * (r >> 2) + 4 * hi; }
__device__ __forceinline__ unsigned cvtpk(float lo, float hi) { unsigned r; asm volatile("v_cvt_pk_bf16_f32 %0, %1, %2" : "=v"(r) : "v"(lo), "v"(hi)); return r; }
__device__ __forceinline__ void partialSM(f32x16& p0, f32x16& p1, float& m_reg, float& mn, float& alpha) {
  constexpr float C = SCALE * 1.4426950408889634f;
  float pmax = p0[0]; for (int r = 1; r < 16; ++r) pmax = fmaxf(pmax, p0[r]); for (int r = 0; r < 16; ++r) pmax = fmaxf(pmax, p1[r]);
  { auto rr = __builtin_amdgcn_permlane32_swap(__float_as_uint(pmax), __float_as_uint(pmax), false, false);
    pmax = fmaxf(__uint_as_float(rr[0]), __uint_as_float(rr[1])); }
  if (__builtin_expect(__all(pmax - m_reg <= THR / SCALE), 1)) { mn = m_reg; alpha = 1.f; }
  else { mn = fmaxf(m_reg, pmax); alpha = __builtin_amdgcn_exp2f((m_reg - mn) * C); m_reg = mn; }
  float mnC = -mn * C;
  for (int r = 0; r < 16; ++r) p0[r] = fmaf(p0[r], C, mnC); for (int r = 0; r < 16; ++r) p1[r] = fmaf(p1[r], C, mnC);
  for (int r = 0; r < 16; ++r) p0[r] = __builtin_amdgcn_exp2f(p0[r]);
}
__device__ __forceinline__ void finishSM(f32x16& p0, f32x16& p1, float alpha, float& l_reg, bf16x8& pa0, bf16x8& pa1, bf16x8& pa2, bf16x8& pa3) {
  for (int r = 0; r < 16; ++r) p1[r] = __builtin_amdgcn_exp2f(p1[r]);
  float ps = 0; for (int r = 0; r < 16; ++r) ps += p0[r]; for (int r = 0; r < 16; ++r) ps += p1[r];
  { auto rr = __builtin_amdgcn_permlane32_swap(__float_as_uint(ps), __float_as_uint(ps), false, false);
    ps = __uint_as_float(rr[0]) + __uint_as_float(rr[1]); }
  l_reg = l_reg * alpha + ps;
#define PK4(P, BASE, OUT) do { unsigned a0 = cvtpk(P[BASE + 0], P[BASE + 1]), a1 = cvtpk(P[BASE + 2], P[BASE + 3]);   \
    unsigned b0 = cvtpk(P[BASE + 4], P[BASE + 5]), b1 = cvtpk(P[BASE + 6], P[BASE + 7]);                              \
    auto r0 = __builtin_amdgcn_permlane32_swap(a0, b0, false, false); auto r1 = __builtin_amdgcn_permlane32_swap(a1, b1, false, false); \
    u32x4 w = {r0[0], r1[0], r0[1], r1[1]}; OUT = *reinterpret_cast<bf16x8*>(&w); } while (0)
  PK4(p0, 0, pa0); PK4(p0, 8, pa1); PK4(p1, 0, pa2); PK4(p1, 8, pa3);
#undef PK4
}
__device__ __forceinline__ void qkt(f32x16& p0, f32x16& p1, const bf16_t* Ks, const bf16x8* qr, int r32, int hi) {
  p0 = f32x16{}; p1 = f32x16{};
#pragma unroll
  for (int d0 = 0; d0 < 8; ++d0) { int cb = (d0 * 16 + hi * 8) * 2;
    bf16x8 b0 = *reinterpret_cast<const bf16x8*>((const char*)Ks + KSWZ(r32, cb));
    bf16x8 b1 = *reinterpret_cast<const bf16x8*>((const char*)Ks + KSWZ(32 + r32, cb));
    p0 = __builtin_amdgcn_mfma_f32_32x32x16_bf16(b0, qr[d0], p0, 0, 0, 0);
    p1 = __builtin_amdgcn_mfma_f32_32x32x16_bf16(b1, qr[d0], p1, 0, 0, 0); }
}
__device__ __forceinline__ int v_st(int k, int c) { const int kk = (k & ~0xC) | ((k & 4) << 1) | ((k & 8) >> 1); return ((kk >> 3) * 4 + (c >> 5)) * 512 + ((kk & 7) * 32 + (c & 31)) * 2; }
__device__ __forceinline__ int v_rd_base(int lane) { return ((lane & 3) << 3) | (((lane >> 2) & 3) << 6) | (((lane >> 4) & 1) << 5) | (((lane >> 5) & 1) << 8); }
constexpr int v_rd_off(int d0, int ks, int half) { return d0 * 512 + ks * 4096 + half * 2048; }
template <int OFF> __device__ __forceinline__ s16x4 tr_read(int vb) {
  s16x4 r; asm volatile("ds_read_b64_tr_b16 %0, %1 offset:%2" : "=&v"(r) : "v"(vb), "i"(OFF) : "memory"); return r;
}
template <int D0> __device__ __forceinline__ void pv_one(f32x16& od, int vb, bf16x8 pa0, bf16x8 pa1, bf16x8 pa2, bf16x8 pa3) {
  const s16x4 l0 = tr_read<v_rd_off(D0, 0, 0)>(vb), h0 = tr_read<v_rd_off(D0, 0, 1)>(vb), l1 = tr_read<v_rd_off(D0, 1, 0)>(vb), h1 = tr_read<v_rd_off(D0, 1, 1)>(vb);
  const s16x4 l2 = tr_read<v_rd_off(D0, 2, 0)>(vb), h2 = tr_read<v_rd_off(D0, 2, 1)>(vb), l3 = tr_read<v_rd_off(D0, 3, 0)>(vb), h3 = tr_read<v_rd_off(D0, 3, 1)>(vb);
  asm volatile("s_waitcnt lgkmcnt(0)" ::: "memory"); SBAR();
#define PK(L, H) (bf16x8){L[0], L[1], L[2], L[3], H[0], H[1], H[2], H[3]}
  od = __builtin_amdgcn_mfma_f32_32x32x16_bf16(pa0, PK(l0, h0), od, 0, 0, 0);
  od = __builtin_amdgcn_mfma_f32_32x32x16_bf16(pa1, PK(l1, h1), od, 0, 0, 0);
  od = __builtin_amdgcn_mfma_f32_32x32x16_bf16(pa2, PK(l2, h2), od, 0, 0, 0);
  od = __builtin_amdgcn_mfma_f32_32x32x16_bf16(pa3, PK(l3, h3), od, 0, 0, 0);
#undef PK
}
__device__ __forceinline__ void pv_d0(f32x16* o, int vb, bf16x8 pa0, bf16x8 pa1, bf16x8 pa2, bf16x8 pa3) {
  pv_one<0>(o[0], vb, pa0, pa1, pa2, pa3); pv_one<1>(o[1], vb, pa0, pa1, pa2, pa3); pv_one<2>(o[2], vb, pa0, pa1, pa2, pa3); pv_one<3>(o[3], vb, pa0, pa1, pa2, pa3);
}
__device__ __forceinline__ void attn_dense_body(const bf16_t* __restrict__ Qb, const bf16_t* __restrict__ Kh, const bf16_t* __restrict__ Vh,
                                                bf16_t* __restrict__ Ob, int seq, char* lds) {
  const int tid = opaque_tid(), wid = tid >> 6, lane = tid & 63, r32 = lane & 31, hi = lane >> 5;
  bf16_t* V_lds = (bf16_t*)lds; bf16_t* K_lds = (bf16_t*)(lds + 2 * SHM_V);
  float* ws = (float*)(lds + 2 * SHM_V + 2 * SHM_K) + wid * 64; float* li_l = ws; float* al_l = ws + 32;
  float m_reg = -1e30f, l_reg = 0; f32x16 o[4] = {}; bf16x8 qr[8];
  const bf16_t* Qw = Qb + (long)(wid * QBLK + r32) * LDQ + hi * 8;
#pragma unroll
  for (int d0 = 0; d0 < 8; ++d0) qr[d0] = *reinterpret_cast<const bf16x8*>(Qw + d0 * 16);
  const int sr = tid >> 4, sc = (tid & 15) * 8, vst0 = v_st(sr, sc), vst1 = v_st(32 + sr, sc);
  const int vb0 = (int)(uintptr_t)V_lds + v_rd_base(lane);
  struct { bf16x8 vs0, vs1, ks0, ks1; } sr_[2];
#define SLOAD(i, k0) do { sr_[i].vs0 = *reinterpret_cast<const bf16x8*>(&Vh[(long)((k0) + sr) * LDK + sc]); sr_[i].vs1 = *reinterpret_cast<const bf16x8*>(&Vh[(long)((k0) + 32 + sr) * LDK + sc]); \
    sr_[i].ks0 = *reinterpret_cast<const bf16x8*>(&Kh[(long)((k0) + sr) * LDK + sc]); sr_[i].ks1 = *reinterpret_cast<const bf16x8*>(&Kh[(long)((k0) + 32 + sr) * LDK + sc]); } while (0)
#define SWRITE(b, i) do { *(bf16x8*)((char*)V_lds + (b) * SHM_V + vst0) = sr_[i].vs0;          \
    *(bf16x8*)((char*)V_lds + (b) * SHM_V + vst1) = sr_[i].vs1; int kc = sc * 2;               \
    *(bf16x8*)((char*)K_lds + (b) * SHM_K + KSWZ(sr, kc)) = sr_[i].ks0;                       \
    *(bf16x8*)((char*)K_lds + (b) * SHM_K + KSWZ(32 + sr, kc)) = sr_[i].ks1; } while (0)
#define SWAIT() asm volatile("s_waitcnt vmcnt(4)" ::: "memory")
#define RESC(a) do { if (__any((a) < 1.f)) { if (hi == 0) al_l[r32] = (a); asm volatile("s_waitcnt lgkmcnt(0)" ::: "memory"); \
    for (int d = 0; d < 4; ++d) for (int r = 0; r < 16; ++r) o[d][r] *= al_l[crow(r, hi)]; } } while (0)
  f32x16 pA0, pA1, pB0, pB1; float mnA, mnB, alA, alB; bf16x8 pa0, pa1, pa2, pa3; const int NT = seq / KVBLK;
  constexpr int SE = 0, SO = 1;
  SLOAD(SE, 0); asm volatile("s_waitcnt vmcnt(0)" ::: "memory"); SWRITE(0, SE); __syncthreads();
  qkt(pA0, pA1, K_lds, qr, r32, hi); partialSM(pA0, pA1, m_reg, mnA, alA);
  SLOAD(SO, KVBLK); if (2 < NT) SLOAD(SE, 2 * KVBLK);
  SWAIT(); SWRITE(1, SO); __syncthreads();
  for (int j = 1; j + 1 < NT; j += 2) {
    SBAR(); qkt(pB0, pB1, (bf16_t*)((char*)K_lds + SHM_K), qr, r32, hi);
    finishSM(pA0, pA1, alA, l_reg, pa0, pa1, pa2, pa3); SBAR();
    SLOAD(SO, (j + 2) * KVBLK); SBAR();
    pv_d0(o, vb0, pa0, pa1, pa2, pa3); partialSM(pB0, pB1, m_reg, mnB, alB);
    __syncthreads(); SWAIT(); SWRITE(0, SE);
    RESC(alB); __syncthreads();
    SBAR(); qkt(pA0, pA1, K_lds, qr, r32, hi);
    finishSM(pB0, pB1, alB, l_reg, pa0, pa1, pa2, pa3); SBAR();
    if (j + 3 < NT) SLOAD(SE, (j + 3) * KVBLK); SBAR();
    pv_d0(o, vb0 + (int)SHM_V, pa0, pa1, pa2, pa3); partialSM(pA0, pA1, m_reg, mnA, alA);
    __syncthreads(); SWAIT(); SWRITE(1, SO);
    RESC(alA); __syncthreads();
  }
  SBAR(); qkt(pB0, pB1, (bf16_t*)((char*)K_lds + SHM_K), qr, r32, hi);
  finishSM(pA0, pA1, alA, l_reg, pa0, pa1, pa2, pa3); SBAR();
  pv_d0(o, vb0, pa0, pa1, pa2, pa3); partialSM(pB0, pB1, m_reg, mnB, alB);
  __syncthreads(); RESC(alB);
  finishSM(pB0, pB1, alB, l_reg, pa0, pa1, pa2, pa3); SBAR();
  pv_d0(o, vb0 + (int)SHM_V, pa0, pa1, pa2, pa3);
  if (hi == 0) li_l[r32] = l_reg; asm volatile("s_waitcnt lgkmcnt(0)" ::: "memory");
  float rli[16];
#pragma unroll
  for (int r = 0; r < 16; ++r) rli[r] = __builtin_amdgcn_rcpf(li_l[crow(r, hi)]);
  bf16_t* Ow = Ob + (long)(wid * QBLK) * LDO;
#pragma unroll
  for (int r = 0; r < 16; ++r) { int orow = crow(r, hi);
#pragma unroll
    for (int d0 = 0; d0 < 4; ++d0) { const float v = o[d0][r] * rli[r]; Ow[(long)orow * LDO + d0 * 32 + r32] = (bf16_t)(cvtpk(v, v) & 0xffffu); } }
#undef SLOAD
#undef SWRITE
#undef SWAIT
#undef RESC
}
}

__device__ __forceinline__ int up_row(int n) { const int n2 = n >= DFF ? n - DFF : n; return 8 * (n2 >> 2) + (n2 & 3) + (n >= DFF ? 4 : 0); }
__device__ __forceinline__ int qkv_row(int n) { const int d = n & 127, a = d >> 6, nn = (d >> 5) & 1, pp = d & 31; return (n & ~127) + 8 * ((32 * a + pp) >> 2) + 4 * nn + (pp & 3); }
__device__ __forceinline__ void transpose_item(const float* W, int K, int N, bf16_t* WT, int rmap, LAS float* scr, int item, int lane) {
    const int nblk = N / 32, kb = item / nblk, nb = item % nblk, k0 = 64 * kb, n0 = 32 * nb;
    float tv[32];
    const float* wp = W + (size_t)(k0 + (lane >> 5)) * N + n0 + (lane & 31);
#pragma unroll
    for (int i = 0; i < 32; ++i) tv[i] = wp[(size_t)(2 * i) * N];
#pragma unroll
    for (int i = 0; i < 32; ++i) scr[(2 * i + (lane >> 5)) * 33 + (lane & 31)] = tv[i];
    asm volatile("s_waitcnt lgkmcnt(0)" ::: "memory");
    const int c = lane & 7;
#pragma unroll
    for (int j = 0; j < 4; ++j) { const int n = (lane >> 3) + 8 * j; const LAS float* s = scr + (8 * c) * 33 + n;
        u32x4 o; o.x = cvt_pk_bf16(s[0 * 33], s[1 * 33]); o.y = cvt_pk_bf16(s[2 * 33], s[3 * 33]); o.z = cvt_pk_bf16(s[4 * 33], s[5 * 33]); o.w = cvt_pk_bf16(s[6 * 33], s[7 * 33]);
        const int dr = rmap == 1 ? up_row(n0 + n) : (rmap == 2 ? qkv_row(n0 + n) : (n0 + n));
        *(u32x4*)(WT + (size_t)dr * K + k0 + 8 * c) = o; }
    asm volatile("s_waitcnt lgkmcnt(0)" ::: "memory");
}

__device__ __forceinline__ void convert_layer_weights(int l, int widx, int nw, LAS unsigned char* lds) {
    const Params p = kparams(); unsigned char* ws = p.ws;
    const int tid = opaque_tid(), lane = tid & 63, wave = __builtin_amdgcn_readfirstlane(tid >> 6);
    LAS float* scr = (LAS float*)(lds + 65536 + wave * 8704);
    constexpr int I_QKV = 16 * 48, I_O = 16 * 32, I_PL = 4 * 8, I_UP = 16 * 176, I_DN = 44 * 32;
    const int nmix = (l & 1) ? 4 * I_PL : I_QKV + I_O, nitems = I_UP + I_DN + nmix, a = l >> 1;
    for (int it = widx; it < nitems; it += nw) {
        int r = it; const float* W; bf16_t* WT; int K, N, sub; int upm = 0;
        if (r < I_UP) { sub = r; W = p.w_up + (size_t)l * DM * 2 * DFF; K = DM; N = 2 * DFF; WT = (bf16_t*)(ws + WS_WUP) + (size_t)l * 2 * DFF * DM; upm = 1; }
        else if ((r -= I_UP) < I_DN) { sub = r; W = p.w_down + (size_t)l * DFF * DM; K = DFF; N = DM; WT = (bf16_t*)(ws + WS_WDN) + (size_t)l * DM * DFF; }
        else if (l & 1) { r -= I_DN; const int pg = a * 4 + r / I_PL; sub = r % I_PL; W = p.w_pool + (size_t)pg * 65536; K = 256; N = 256; WT = (bf16_t*)(ws + WS_WPOOL) + (size_t)pg * 65536; }
        else if ((r -= I_DN) < I_QKV) { sub = r; W = p.w_qkv + (size_t)a * DM * QKVW; K = DM; N = QKVW; WT = (bf16_t*)(ws + WS_WQKV) + (size_t)a * QKVW * DM; upm = 2; }
        else { sub = r - I_QKV; W = p.w_o + (size_t)a * DM * DM; K = DM; N = DM; WT = (bf16_t*)(ws + WS_WO) + (size_t)a * DM * DM; }
        transpose_item(W, K, N, WT, upm, scr, sub, lane);
    }
}

__device__ __forceinline__ void mod_items(int item_begin, int item_end, int bidx, int nblk, LAS unsigned char* lds) {
    const Params p = kparams();
    const int tid = opaque_tid();
    LAS float* sil = (LAS float*)lds;
    LAS float* red = (LAS float*)(lds + 20480);
    if (item_begin + bidx >= item_end) return;
    for (int i = tid; i < 5 * DM; i += 512) { const int cnd = i >> 10, k = i & 1023; const float v = cnd == 0 ? p.c_ctx[k] : p.c[(cnd - 1) * DM + k]; sil[i] = silu_f(v); }
    __syncthreads();
    float* modo = (float*)(p.ws + WS_MOD);
    for (int item = item_begin + bidx; item < item_end; item += nblk) {
        const int l = item / 192, col0 = (item % 192) * 32, cgp = tid & 7, kr = tid >> 3;
        f32x4 acc[5];
#pragma unroll
        for (int cnd = 0; cnd < 5; ++cnd) acc[cnd] = (f32x4){0.f, 0.f, 0.f, 0.f};
        const float* wp = p.w_ada + ((size_t)l * DM + kr) * NMODW + col0 + 4 * cgp;
        f32x4 w4[16];
#pragma unroll
        for (int i = 0; i < 16; ++i) w4[i] = *(const f32x4*)(wp + (size_t)i * 64 * NMODW);
#pragma unroll
        for (int i = 0; i < 16; ++i) { const int k = kr + 64 * i;
#pragma unroll
            for (int cnd = 0; cnd < 5; ++cnd) acc[cnd] += w4[i] * sil[cnd * DM + k]; }
#pragma unroll
        for (int cnd = 0; cnd < 5; ++cnd) *(LAS f32x4*)(red + (kr * 5 + cnd) * 32 + 4 * cgp) = acc[cnd];
        __syncthreads();
        if (tid < 160) { const int cnd = tid >> 5, col = tid & 31; float s = 0.f;
#pragma unroll 8
            for (int k2 = 0; k2 < 64; ++k2) s += red[(k2 * 5 + cnd) * 32 + col];
            modo[(size_t)(l * 5 + cnd) * NMODW + col0 + col] = s + p.b_ada[l * NMODW + col0 + col]; }
        __syncthreads();
    }
}

__device__ __forceinline__ void prep_phase(LAS unsigned char* lds) {
    const Params p = kparams();
    const int tid = opaque_tid(), lane = tid & 63, wave = __builtin_amdgcn_readfirstlane(tid >> 6), G = gridDim.x, gw = blockIdx.x * NWAVES + wave, NGW = G * NWAVES; (void)tid; (void)lane; (void)wave; (void)gw; (void)NGW; (void)G;
    unsigned char* ws = p.ws;
    convert_layer_weights(0, gw, NGW, lds);
    for (int it = gw; it < 2 * 4 * PAST; it += NGW) {
        const int alx = it >> 11, idx = it & 2047, b = idx >> 9, pp = idx & (PAST - 1);
        const size_t srco = ((size_t)(b * 2 + alx) * PAST + pp) * KVW + lane * 4, dst = ((size_t)b * KV_S + SEQ_S + pp) * KVW + lane * 4;
        const f32x4 kv = *(const f32x4*)(p.cache_k + srco), vv = *(const f32x4*)(p.cache_v + srco);
        u32x2 wk, wv; wk.x = cvt_pk_bf16(kv[0], kv[1]); wk.y = cvt_pk_bf16(kv[2], kv[3]); wv.x = cvt_pk_bf16(vv[0], vv[1]); wv.y = cvt_pk_bf16(vv[2], vv[3]);
        *(u32x2*)((bf16_t*)(ws + WS_KS + (size_t)alx * KVS_LAYER) + dst) = wk; *(u32x2*)((bf16_t*)(ws + WS_VS + (size_t)alx * KVS_LAYER) + dst) = wv;
    }
}

__device__ __forceinline__ void rowpass(const float* xsrc_p, const float* xsrc_s, float* xdst, const float* yraw,
                                        const float* modg, int gate_idx, const float* g_post, const float* modh, int shift_idx, const float* g_pre, bf16_t* H, bf16_t* X16) {
    const int tid = opaque_tid(), lane = tid & 63, wave = __builtin_amdgcn_readfirstlane(tid >> 6), G = gridDim.x, gw = blockIdx.x * NWAVES + wave, NGW = G * NWAVES; (void)tid; (void)lane; (void)wave; (void)gw; (void)NGW; (void)G;
    for (int r0 = gw * 8; r0 < NTOK; r0 += NGW * 8) {
        const int cond = r0 < NP ? 0 : 1 + ((r0 - NP) >> 11);
        f32x4 Gv[4], Av[4], Bv[4];
#pragma unroll
        for (int j = 0; j < 4; ++j) { const int col = 4 * lane + 256 * j;
            Gv[j] = (f32x4){0.f, 0.f, 0.f, 0.f}; Av[j] = Gv[j]; Bv[j] = Gv[j];
            if (yraw) Gv[j] = *(const f32x4*)(modg + (size_t)cond * NMODW + gate_idx * DM + col) * *(const f32x4*)(g_post + col);
            if (H) { const f32x4 sh = *(const f32x4*)(modh + (size_t)cond * NMODW + shift_idx * DM + col), scl = *(const f32x4*)(modh + (size_t)cond * NMODW + (shift_idx + 1) * DM + col);
                Av[j] = *(const f32x4*)(g_pre + col) * (scl + 1.0f); Bv[j] = sh; } }
#pragma unroll 4
        for (int i = 0; i < 8; ++i) { const int row = r0 + i;
            const float* xr = row < NP ? xsrc_p + (size_t)row * DM : xsrc_s + (size_t)(row - NP) * DM;
            f32x4 v[4];
#pragma unroll
            for (int j = 0; j < 4; ++j) v[j] = *(const f32x4*)(xr + 4 * lane + 256 * j);
            if (yraw) { f32x4 y[4]; float ss = 0.f;
#pragma unroll
                for (int j = 0; j < 4; ++j) { y[j] = *(const f32x4*)(yraw + (size_t)row * DM + 4 * lane + 256 * j); ss += (y[j][0] * y[j][0] + y[j][1] * y[j][1]) + (y[j][2] * y[j][2] + y[j][3] * y[j][3]); }
                const float rs = 1.0f / sqrtf(wave_sum(ss) * (1.0f / DM) + EPS);
#pragma unroll
                for (int j = 0; j < 4; ++j) v[j] += Gv[j] * (y[j] * rs); }
            if (xdst) {
#pragma unroll
                for (int j = 0; j < 4; ++j) *(f32x4*)(xdst + (size_t)row * DM + 4 * lane + 256 * j) = v[j]; }
            if (X16) {
#pragma unroll
                for (int j = 0; j < 4; ++j) { u32x2 w; w.x = cvt_pk_bf16(v[j][0], v[j][1]); w.y = cvt_pk_bf16(v[j][2], v[j][3]); *(u32x2*)(X16 + (size_t)row * DM + 4 * lane + 256 * j) = w; } }
            if (H) { float ss = 0.f;
#pragma unroll
                for (int j = 0; j < 4; ++j) ss += (v[j][0] * v[j][0] + v[j][1] * v[j][1]) + (v[j][2] * v[j][2] + v[j][3] * v[j][3]);
                const float rs = 1.0f / sqrtf(wave_sum(ss) * (1.0f / DM) + EPS);
#pragma unroll
                for (int j = 0; j < 4; ++j) { const f32x4 h = (v[j] * rs) * Av[j] + Bv[j]; u32x2 w; w.x = cvt_pk_bf16(h[0], h[1]); w.y = cvt_pk_bf16(h[2], h[3]);
                    *(u32x2*)(H + (size_t)row * DM + 4 * lane + 256 * j) = w; } }
        }
    }
}

template <int GI> __device__ __forceinline__ void pool_item(const bf16_t* H, bf16_t* P, int chunk, int lane) {
    constexpr int half = 1 << GI, NR = 31 + 2 * half;
    const int t0 = chunk * 32;
    int ss, T; if (t0 < NP) { ss = t0 & ~(SEQ_P - 1); T = SEQ_P; } else { ss = NP + ((t0 - NP) & ~(SEQ_S - 1)); T = SEQ_S; }
    const int tl0 = t0 - ss;
    const bf16_t* base = H + (size_t)ss * DM + GI * 256 + lane * 4;
    u32x2 v[NR];
#pragma unroll
    for (int i = 0; i < NR; ++i) { const int rl = tl0 - half + i; const bool ok = (rl >= 0) && (rl < T); const u32x2 x = *(const u32x2*)(base + (size_t)(ok ? rl : tl0) * DM); v[i].x = ok ? x.x : 0u; v[i].y = ok ? x.y : 0u; }
    f32x4 S = (f32x4){0.f, 0.f, 0.f, 0.f};
#pragma unroll
    for (int i = 0; i < 2 * half; ++i) { S[0] += bf_lo(v[i].x); S[1] += bf_hi(v[i].x); S[2] += bf_lo(v[i].y); S[3] += bf_hi(v[i].y); }
    bf16_t* out = P + (size_t)t0 * DM + GI * 256 + lane * 4;
#pragma unroll
    for (int j = 0; j < 32; ++j) { const int tl = tl0 + j; const int lo = tl - half < 0 ? 0 : tl - half, hi = tl + half > T ? T : tl + half; const float inv = 1.0f / (float)(hi - lo);
        const u32x2 c = v[j + half]; u32x2 w; w.x = cvt_pk_bf16(S[0] * inv - bf_lo(c.x), S[1] * inv - bf_hi(c.x)); w.y = cvt_pk_bf16(S[2] * inv - bf_lo(c.y), S[3] * inv - bf_hi(c.y));
        *(u32x2*)(out + (size_t)j * DM) = w;
        if (j < 31) { const u32x2 a = v[j + 2 * half], d = v[j]; S[0] += bf_lo(a.x) - bf_lo(d.x); S[1] += bf_hi(a.x) - bf_hi(d.x); S[2] += bf_lo(a.y) - bf_lo(d.y); S[3] += bf_hi(a.y) - bf_hi(d.y); } }
}
template <int GI> __device__ __forceinline__ void pool_item_x(const bf16_t* X16, const float* RS, f32x4 Av, bf16_t* P, int chunk, int lane) {
    constexpr int half = 1 << GI, NR = 31 + 2 * half;
    const int t0 = chunk * 32;
    int ss, T; if (t0 < NP) { ss = t0 & ~(SEQ_P - 1); T = SEQ_P; } else { ss = NP + ((t0 - NP) & ~(SEQ_S - 1)); T = SEQ_S; }
    const int tl0 = t0 - ss;
    const bf16_t* base = X16 + (size_t)ss * DM + GI * 256 + lane * 4;
    u32x2 v[NR]; float rv[NR];
#pragma unroll
    for (int i = 0; i < NR; ++i) { const int rl = tl0 - half + i; const bool ok = (rl >= 0) && (rl < T); const int rc = ok ? rl : tl0;
        const u32x2 x = *(const u32x2*)(base + (size_t)rc * DM); v[i].x = ok ? x.x : 0u; v[i].y = ok ? x.y : 0u; rv[i] = RS[ss + rc]; }
#define XH(i) ((f32x4){bf_lo(v[i].x), bf_hi(v[i].x), bf_lo(v[i].y), bf_hi(v[i].y)} * rv[i])
    f32x4 S = (f32x4){0.f, 0.f, 0.f, 0.f};
#pragma unroll
    for (int i = 0; i < 2 * half; ++i) S += XH(i);
    bf16_t* out = P + (size_t)t0 * DM + GI * 256 + lane * 4;
#pragma unroll
    for (int j = 0; j < 32; ++j) { const int tl = tl0 + j; const int lo = tl - half < 0 ? 0 : tl - half, hi = tl + half > T ? T : tl + half; const float inv = 1.0f / (float)(hi - lo);
        const f32x4 o = Av * (S * inv - XH(j + half)); u32x2 w; w.x = cvt_pk_bf16(o[0], o[1]); w.y = cvt_pk_bf16(o[2], o[3]);
        *(u32x2*)(out + (size_t)j * DM) = w;
        if (j < 31) S += XH(j + 2 * half) - XH(j); }
#undef XH
}
__device__ __forceinline__ void pool_local(int l, bf16_t* P, int pm, int pn) {
    const Params p = kparams();
    const int tid = opaque_tid(), lane = tid & 63, wave = __builtin_amdgcn_readfirstlane(tid >> 6);
    const int chunk = pm * 8 + wave, rowt = pm * 256, cond = rowt < NP ? 0 : 1 + ((rowt - NP) >> 11), col = pn * 256 + lane * 4;
    const float* mod = (const float*)(p.ws + WS_MOD) + ((size_t)l * 5 + cond) * NMODW;
    const f32x4 Av = *(const f32x4*)(p.norm_gains + (size_t)(l * 4) * DM + col) * (*(const f32x4*)(mod + DM + col) + 1.0f);
    const bf16_t* X16 = (const bf16_t*)(p.ws + WS_X16 + (l == 3 ? X16_COPY : 0)); const float* RS = (const float*)(p.ws + WS_RS);
    if (pn == 0) pool_item_x<0>(X16, RS, Av, P, chunk, lane); else if (pn == 1) pool_item_x<1>(X16, RS, Av, P, chunk, lane); else if (pn == 2) pool_item_x<2>(X16, RS, Av, P, chunk, lane); else pool_item_x<3>(X16, RS, Av, P, chunk, lane);
    asm volatile("s_waitcnt vmcnt(0)" ::: "memory");
    __builtin_amdgcn_fence(__ATOMIC_ACQUIRE, "agent");
    asm volatile("s_waitcnt vmcnt(0)" ::: "memory");
    __syncthreads();
}
__device__ __forceinline__ void pool_pass(const bf16_t* H, bf16_t* P) {
    const int tid = opaque_tid(), lane = tid & 63, wave = __builtin_amdgcn_readfirstlane(tid >> 6), gw = blockIdx.x * NWAVES + wave, NGW = gridDim.x * NWAVES;
    for (int it = gw; it < (NTOK / 32) * 4; it += NGW) { const int chunk = it >> 2, g = it & 3;
        if (g == 0) pool_item<0>(H, P, chunk, lane); else if (g == 1) pool_item<1>(H, P, chunk, lane); else if (g == 2) pool_item<2>(H, P, chunk, lane); else pool_item<3>(H, P, chunk, lane); }
}

__device__ __forceinline__ void attn_phase(char* lds, int G, int al) {
    const Params p = kparams();
    unsigned char* ws = p.ws;
    const bf16_t* qkv = (const bf16_t*)(ws + WS_QKV); const bf16_t* Kp = (const bf16_t*)(ws + WS_KP); const bf16_t* Ks = (const bf16_t*)(ws + WS_KS + (size_t)al * KVS_LAYER);
    const bf16_t* Vp = (const bf16_t*)(ws + WS_VP); const bf16_t* Vs = (const bf16_t*)(ws + WS_VS + (size_t)al * KVS_LAYER); bf16_t* AO = (bf16_t*)(ws + WS_ATTO);
#pragma unroll 1
    for (int u = vcu(); u < 512; u += G) {
        const bf16_t *Qb, *Kh, *Vh; bf16_t* Ob; int seq;
        if (u < 256) { const int combo = u & 7, b = combo >> 1, kvh = combo & 1, w = u >> 3, hq = kvh * 4 + (w >> 3), qb = w & 7;
            const size_t row0 = (size_t)NP + b * SEQ_S + qb * 256;
            Qb = qkv + row0 * DM + hq * 128; Kh = Ks + (size_t)b * KV_S * KVW + kvh * 128; Vh = Vs + (size_t)b * KV_S * KVW + kvh * 128; Ob = AO + row0 * DM + hq * 128; seq = KV_S; }
        else { const int u2 = u - 256, b = u2 >> 3, hq = u2 & 7, kvh = hq >> 2; const size_t row0 = (size_t)b * SEQ_P;
            Qb = qkv + row0 * DM + hq * 128; Kh = Kp + row0 * KVW + kvh * 128; Vh = Vp + row0 * KVW + kvh * 128; Ob = AO + row0 * DM + hq * 128; seq = SEQ_P; }
        attn::attn_dense_body(Qb, Kh, Vh, Ob, seq, lds);
        __syncthreads();
    }
}


#define XB_TMO      128
#define XB_XCNT(j)  (256  + 64 * (j))
#define XB_XSUB(j)  (1280 + 64 * (j))
#define XB_XGEN(j)  (2304 + 64 * (j))
#define XB_TOP      3328
#define XB_TOPGEN   3392
#define XCD_BAR_WORDS 3456
#define XB_SPIN_CAP (1u << 18)
__device__ __forceinline__ unsigned xb_ld(unsigned* p)              { return __hip_atomic_load(p, __ATOMIC_RELAXED, __HIP_MEMORY_SCOPE_AGENT); }
__device__ __forceinline__ unsigned xb_add(unsigned* p, unsigned v) { return __hip_atomic_fetch_add(p, v, __ATOMIC_RELAXED, __HIP_MEMORY_SCOPE_AGENT); }
__device__ __forceinline__ unsigned xb_xcc_id() { return (unsigned)__builtin_amdgcn_s_getreg((3 << 11) | 20) & 0xFu; }
#define XB_SPIN(cond, bar) do { unsigned _sp = 0; while (cond) { __builtin_amdgcn_s_sleep(1); \
    if ((++_sp & 255u) == 0u) { if (xb_ld(&(bar)[XB_TMO])) break; if (_sp > XB_SPIN_CAP) { atomicAdd(&(bar)[XB_TMO], 1u); break; } } } } while (0)
__device__ __forceinline__ void xcd_barrier_post(unsigned* bar, volatile LAS unsigned* misc) {
    if (opaque_tid() == 0) { const unsigned x = xb_xcc_id(); misc[16] = xb_add(&bar[XB_XCNT(x)], 1u); misc[17] = x; }
}
__device__ __forceinline__ void xcd_barrier_complete(unsigned* bar, unsigned x, unsigned& nloc, unsigned& nx) {
    const unsigned G = gridDim.x * gridDim.y * gridDim.z;
    unsigned sum, cnt, mine, sp = 0u;
    for (;;) {
        sum = 0u; cnt = 0u; mine = 0u;
#pragma unroll
        for (unsigned j = 0; j < 16; ++j) { const unsigned c = xb_ld(&bar[XB_XCNT(j)]); sum += c; cnt += (c > 0u) ? 1u : 0u; mine = (j == x) ? c : mine; }
        if (sum == G) break;
        __builtin_amdgcn_s_sleep(1);
        if ((++sp & 255u) == 0u) { if (xb_ld(&bar[XB_TMO])) break; if (sp > XB_SPIN_CAP) { atomicAdd(&bar[XB_TMO], 1u); break; } }
    }
    nloc = mine > 0u ? mine : 1u; nx = cnt > 0u ? cnt : 1u;
}
__device__ __forceinline__ bool xcd_census_uniform(unsigned* bar) {
    bool ok = (gridDim.x == 256);
#pragma unroll
    for (unsigned j = 0; j < 16; ++j) { const unsigned c = xb_ld(&bar[XB_XCNT(j)]); ok = ok && (j < 8u ? c == 32u : c == 0u); }
    return ok;
}
extern __shared__ __attribute__((aligned(16))) unsigned char lds_raw[];
constexpr int MISC_OFF = 147456 - 128;
#define SEAM_PREFETCH_ISSUE() unsigned pf_v_ = 0u; const int pf_t_ = opaque_tid(); const bool pf_on_ = (pfB != nullptr) && (pf_t_ >= 64); \
    if (pf_on_) { const int i_ = pf_t_ - 64; const char* a_ = (const char*)pfB + (size_t)(i_ >> 1) * (size_t)pfK * 2u + (size_t)(i_ & 1) * 128u; \
        asm volatile("global_load_dword %0, %1, off" : "=v"(pf_v_) : "v"(a_) : "memory"); }
#define SEAM_PREFETCH_RETIRE() if (pf_on_) { asm volatile("s_waitcnt vmcnt(0)" : "+v"(pf_v_) :: "memory"); }
__device__ __forceinline__ void xcd_barrier_now(const bf16_t* pfB = nullptr, int pfK = 0) {
    asm volatile("s_waitcnt vmcnt(0)" ::: "memory");
    __syncthreads();
    SEAM_PREFETCH_ISSUE();
    if (opaque_tid() == 0) {
        const Params kp = kparams();
        unsigned* bar = (unsigned*)kp.ws + CW_BAR; const unsigned x = xb_xcc_id();
        volatile LAS unsigned* st = (volatile LAS unsigned*)((LAS unsigned char*)lds_raw + MISC_OFF + 32);
        __builtin_amdgcn_s_waitcnt(0);
        unsigned nloc = st[0], nx = st[1];
        if (nloc == 0u) { xcd_barrier_complete(bar, x, nloc, nx); st[0] = nloc; st[1] = nx; st[10] = xcd_census_uniform(bar) ? 1u : 0u; }
        const unsigned old = xb_add(&bar[XB_XSUB(x)], 1u);
        const unsigned gen = old / nloc;
        if (old + 1u == (gen + 1u) * nloc) {
            __builtin_amdgcn_fence(__ATOMIC_RELEASE, "agent");
            asm volatile("s_waitcnt vmcnt(0)" ::: "memory");
            const unsigned og = xb_add(&bar[XB_TOP], 1u);
            const unsigned tg = og / nx;
            if (og + 1u == (tg + 1u) * nx) xb_add(&bar[XB_TOPGEN], 1u);
            else XB_SPIN(xb_ld(&bar[XB_TOPGEN]) == tg, bar);
            __builtin_amdgcn_fence(__ATOMIC_ACQUIRE, "agent");
            xb_add(&bar[XB_XGEN(x)], 1u);
            asm volatile("s_waitcnt vmcnt(0)" ::: "memory");
        } else {
            XB_SPIN(xb_ld(&bar[XB_XGEN(x)]) == gen, bar);
            __builtin_amdgcn_fence(__ATOMIC_ACQUIRE, "agent");
            asm volatile("s_waitcnt vmcnt(0)" ::: "memory");
        }
    }
    __syncthreads();
    SEAM_PREFETCH_RETIRE();
}


__device__ __forceinline__ bool census_uniform() { return ((volatile LAS unsigned*)((LAS unsigned char*)lds_raw + MISC_OFF))[18] != 0u; }
__device__ __forceinline__ int vcu() {
    volatile LAS unsigned* misc = (volatile LAS unsigned*)((LAS unsigned char*)lds_raw + MISC_OFF);
    const unsigned v = misc[18] != 0u ? misc[16] * 8u + misc[17] : blockIdx.x;
    return __builtin_amdgcn_readfirstlane((int)v);
}
__device__ __forceinline__ void xcc_barrier_now(const bf16_t* pfB = nullptr, int pfK = 0) {
    if (!census_uniform()) { xcd_barrier_now(pfB, pfK); return; }
    asm volatile("s_waitcnt vmcnt(0)" ::: "memory");
    __syncthreads();
    SEAM_PREFETCH_ISSUE();
    if (opaque_tid() == 0) {
        const Params kp = kparams();
        unsigned* ctl = (unsigned*)kp.ws; unsigned* bar = ctl + CW_BAR; const unsigned x = xb_xcc_id();
        __builtin_amdgcn_s_waitcnt(0);
        const unsigned old = xb_add(&ctl[1024 + 64 * x], 1u);
        const unsigned gen = old / 32u;
        if (old + 1u == (gen + 1u) * 32u) xb_add(&ctl[2048 + 64 * x], 1u);
        else XB_SPIN(xb_ld(&ctl[2048 + 64 * x]) == gen, bar);
        __builtin_amdgcn_fence(__ATOMIC_ACQUIRE, "agent");
        asm volatile("s_waitcnt vmcnt(0)" ::: "memory");
    }
    __syncthreads();
    SEAM_PREFETCH_RETIRE();
}

__device__ __forceinline__ int first_pn(int N) { pg8::StaticOrder S; S.init(NTOK, N, (int)gridDim.x, vcu()); pg8::Unit u; u.pm = 0; u.pn = 0; S.next(0, u); return u.pn; }

__global__ void __launch_bounds__(NWAVES * 64, 2) mega_fwd(Params p_unused) {
    cg::grid_group grid = cg::this_grid();
    LAS unsigned char* lds = (LAS unsigned char*)lds_raw;
    const int G = gridDim.x;
    volatile LAS unsigned* MISC = (volatile LAS unsigned*)(lds + MISC_OFF);
    if (threadIdx.x < 32) MISC[threadIdx.x] = 0u;
    __syncthreads();
    { const Params p = kparams(); xcd_barrier_post((unsigned*)p.ws + CW_BAR, MISC); }

    mod_items(0, 192, (int)blockIdx.x, G, lds);
    if (gridDim.y == 12345u) grid.sync();
    xcd_barrier_now();
    { const Params p = kparams(); const float* mod = (const float*)(p.ws + WS_MOD);
      rowpass(p.x_prompt, p.x_sample, nullptr, nullptr, mod, 5, p.norm_gains, mod, 0, p.norm_gains, (bf16_t*)(p.ws + WS_H), (bf16_t*)(p.ws + WS_X16)); }
    prep_phase(lds);
    xcd_barrier_now();

    unsigned seq = 0;
#pragma unroll 1
    for (int l = 0; l < 4; ++l) {
        if ((l & 1) == 0) {
            const int al = l >> 1;
            { const Params p = kparams();
              pg8::Gemm g{(const bf16_t*)(p.ws + WS_H), (const bf16_t*)(p.ws + WS_WQKV) + (size_t)al * QKVW * DM, NTOK, QKVW, DM, DM, 0};
              pg8::StaticOrder S; S.init(NTOK, QKVW, G, vcu());
              pg8::EpiQKV E{al};
              pg8::gemm_phase<pg8::EpiQKV, pg8::StaticOrder, true>(lds, g, S, E);
            }
            if (l == 0) { const int R = (64 * 6) % G, nidle = R ? G - R : G, bi = R ? vcu() - R : vcu();
                if (bi >= 0) mod_items(192, 768, bi, nidle, lds); }
            xcd_barrier_now();
            attn_phase((char*)lds_raw, G, al);
            { const Params p = kparams(); xcd_barrier_now((const bf16_t*)(p.ws + WS_WO) + (size_t)al * DM * DM + (size_t)first_pn(DM) * 256 * DM, DM); }
        } else {
            const Params p = kparams();
            if (G == 256) { pg8::StaticOrder S; S.init(NTOK, DM, G, vcu()); pg8::Unit u; S.next(0, u);
                pool_local(l, (bf16_t*)(p.ws + WS_QKV), u.pm, u.pn); }
            else { pool_pass((const bf16_t*)(p.ws + WS_H), (bf16_t*)(p.ws + WS_QKV)); xcd_barrier_now(); }
        }
        { const Params p = kparams();
          pg8::Gemm gm;
          if ((l & 1) == 0) gm = pg8::Gemm{(const bf16_t*)(p.ws + WS_ATTO), (const bf16_t*)(p.ws + WS_WO) + (size_t)(l >> 1) * DM * DM, NTOK, DM, DM, DM, 0};
          else gm = pg8::Gemm{(const bf16_t*)(p.ws + WS_QKV), (const bf16_t*)(p.ws + WS_WPOOL) + (size_t)(l >> 1) * DM * 256, NTOK, DM, 256, DM, 256};
          pg8::StaticOrder S; S.init(NTOK, DM, G, vcu());
          pg8::EpiFused E{l, 0, 32u * (seq + 1u)}; ++seq;
          pg8::gemm_phase<pg8::EpiFused, pg8::StaticOrder, false>(lds, gm, S, E); }
        { const Params p = kparams(); xcc_barrier_now((const bf16_t*)(p.ws + WS_WUP) + (size_t)l * 2 * DFF * DM + (size_t)first_pn(2 * DFF) * 256 * DM, DM); }
        { const Params p = kparams();
          pg8::Gemm g{(const bf16_t*)(p.ws + WS_H), (const bf16_t*)(p.ws + WS_WUP) + (size_t)l * 2 * DFF * DM, NTOK, 2 * DFF, DM, DM, 0};
          pg8::StaticOrder S; S.init(NTOK, 2 * DFF, G, vcu());
          pg8::EpiSwiGLU E{(bf16_t*)(p.ws + WS_ACT)};
          pg8::gemm_phase<pg8::EpiSwiGLU, pg8::StaticOrder, true>(lds, g, S, E);
        }
        if (l < 3) { const int R = (64 * 22) % G, nidle = R ? G - R : G; const int bi = R ? vcu() - R : vcu();
            if (bi >= 0) convert_layer_weights(l + 1, bi * NWAVES + __builtin_amdgcn_readfirstlane(opaque_tid() >> 6), nidle * NWAVES, lds); }
        { const Params p = kparams(); const bf16_t* pf = (const bf16_t*)(p.ws + WS_WDN) + (size_t)l * DM * DFF + (size_t)first_pn(DM) * 256 * DFF;
          if (l < 3) xcd_barrier_now(pf, DFF);
          else xcc_barrier_now(pf, DFF); }
        { const Params p = kparams();
          pg8::Gemm g{(const bf16_t*)(p.ws + WS_ACT), (const bf16_t*)(p.ws + WS_WDN) + (size_t)l * DM * DFF, NTOK, DM, DFF, DFF, 0};
          pg8::StaticOrder S; S.init(NTOK, DM, G, vcu());
          pg8::EpiFused E{l, 1, 32u * (seq + 1u)}; ++seq;
          pg8::gemm_phase<pg8::EpiFused, pg8::StaticOrder, false>(lds, g, S, E); }
        if (l < 3) xcc_barrier_now();
    }
}

extern "C" void kernel_launch(void* const* d_in, const int* in_sizes, int n_in, void* d_out, int out_size, void* d_ws, size_t ws_size, hipStream_t stream) {
    static int grid = 0;
    if (grid == 0) {
        if (n_in != 16 || ws_size < WS_END) { fprintf(stderr, "kernel_launch: unexpected n_in %d / ws_size %zu (need %zu)\n", n_in, ws_size, (size_t)WS_END); grid = -1; return; }
        int dev = 0, cus = 0, per_cu = 0;
        if (hipGetDevice(&dev) != hipSuccess || hipDeviceGetAttribute(&cus, hipDeviceAttributeMultiprocessorCount, dev) != hipSuccess) { grid = -1; return; }
        if (hipFuncSetAttribute((const void*)mega_fwd, hipFuncAttributeMaxDynamicSharedMemorySize, LDS_BYTES) != hipSuccess) { fprintf(stderr, "kernel_launch: hipFuncSetAttribute failed\n"); grid = -1; return; }
        if (hipOccupancyMaxActiveBlocksPerMultiprocessor(&per_cu, (const void*)mega_fwd, NWAVES * 64, LDS_BYTES) != hipSuccess || per_cu < 1) { fprintf(stderr, "kernel_launch: occupancy query says %d\n", per_cu); per_cu = 1; }
        (void)hipGetLastError();
        grid = cus;
    }
    if (grid < 0) return;
    if (hipMemsetAsync(d_ws, 0, CTL_ZERO_BYTES, stream) != hipSuccess) { fprintf(stderr, "kernel_launch: memset failed\n"); return; }
    Params p{};
    p.x_prompt = (const float*)d_in[0]; p.x_sample = (const float*)d_in[1]; p.c = (const float*)d_in[2]; p.cache_k = (const float*)d_in[3]; p.cache_v = (const float*)d_in[4];
    p.c_ctx = (const float*)d_in[5]; p.w_ada = (const float*)d_in[6]; p.b_ada = (const float*)d_in[7]; p.norm_gains = (const float*)d_in[8]; p.w_qkv = (const float*)d_in[9];
    p.qk_gains = (const float*)d_in[10]; p.w_o = (const float*)d_in[11]; p.w_pool = (const float*)d_in[12]; p.pool_scale = (const float*)d_in[13]; p.w_up = (const float*)d_in[14]; p.w_down = (const float*)d_in[15];
    p.out = (float*)d_out; p.ws = (unsigned char*)d_ws;
    void* args[] = {&p};
    const hipError_t e = hipLaunchCooperativeKernel((const void*)mega_fwd, dim3(grid), dim3(NWAVES * 64), args, LDS_BYTES, stream);
    if (e != hipSuccess) fprintf(stderr, "kernel_launch: cooperative launch failed: %s (grid %d)\n", hipGetErrorString(e), grid);
}
```

```cpp
#include <hip/hip_runtime.h>
#include <hip/hip_cooperative_groups.h>
#include <hip/hip_bf16.h>
#include <cstdio>
#include <cstdint>
namespace cg = cooperative_groups;

#define LAS __attribute__((address_space(3)))
typedef unsigned short bf16_t;
typedef short bf16x8 __attribute__((ext_vector_type(8)));
typedef short s16x4 __attribute__((ext_vector_type(4)));
typedef float f32x4 __attribute__((ext_vector_type(4)));
typedef float f32x16 __attribute__((ext_vector_type(16)));
typedef unsigned u32x4 __attribute__((ext_vector_type(4)));
typedef unsigned u32x2 __attribute__((ext_vector_type(2)));

constexpr int DM = 1024, NP = 8192, NS = 8192, NTOK = NP + NS, DFF = 2816, QKVW = 1536, NMODW = 6144;
constexpr int SEQ_P = 256, SEQ_S = 2048, PAST = 512, KV_S = SEQ_S + PAST, KVW = 256;
constexpr float EPS = 1e-6f;
constexpr int NWAVES = 8;

constexpr size_t MiB = 1u << 20;
constexpr size_t WS_WQKV = 1 * MiB;
constexpr size_t WS_WO = 7 * MiB;
constexpr size_t WS_WPOOL = 11 * MiB;
constexpr size_t WS_WUP = 12 * MiB;
constexpr size_t WS_WDN = 56 * MiB;
constexpr size_t WS_MOD = 78 * MiB;
constexpr size_t WS_H = 80 * MiB;
constexpr size_t WS_X16 = 112 * MiB;
constexpr size_t X16_COPY = 32 * MiB;
constexpr size_t WS_MIX = 176 * MiB;
constexpr size_t WS_QKV = WS_MIX;
constexpr size_t WS_KP = WS_MIX + 32 * MiB;
constexpr size_t WS_VP = WS_MIX + 36 * MiB;
constexpr size_t WS_ATTO = WS_MIX + 40 * MiB;
constexpr size_t WS_KS = WS_MIX + 72 * MiB;
constexpr size_t WS_VS = WS_MIX + 82 * MiB;
constexpr size_t WS_ACT = WS_MIX + 92 * MiB;
constexpr size_t KVS_LAYER = 5 * MiB;
constexpr size_t WS_END = WS_MIX + 180 * MiB;

constexpr size_t CTL_ZERO_BYTES = 65536; constexpr int CW_BAR = 4096, CW_SEAM = 8192;
constexpr size_t WS_XB1 = 79 * MiB, WS_XB2 = 79 * MiB + 524288;
constexpr size_t WS_RS = 655360;
constexpr int LDS_BYTES = 147456;

struct Params {
    const float *x_prompt, *x_sample, *c, *cache_k, *cache_v, *c_ctx, *w_ada, *b_ada, *norm_gains, *w_qkv, *qk_gains, *w_o, *w_pool, *pool_scale, *w_up, *w_down;
    float* out; unsigned char* ws;
};

typedef const __attribute__((address_space(4))) Params* KParamsPtr;
__device__ __forceinline__ Params kparams() {
    KParamsPtr q = (KParamsPtr)__builtin_amdgcn_kernarg_segment_ptr(); asm volatile("" : "+s"(q));
    Params p;
    p.x_prompt = q->x_prompt; p.x_sample = q->x_sample; p.c = q->c; p.cache_k = q->cache_k; p.cache_v = q->cache_v; p.c_ctx = q->c_ctx; p.w_ada = q->w_ada; p.b_ada = q->b_ada;
    p.norm_gains = q->norm_gains; p.w_qkv = q->w_qkv; p.qk_gains = q->qk_gains; p.w_o = q->w_o; p.w_pool = q->w_pool; p.pool_scale = q->pool_scale; p.w_up = q->w_up; p.w_down = q->w_down;
    p.out = q->out; p.ws = q->ws;
    return p;
}

__device__ __forceinline__ unsigned cvt_pk_bf16(float lo, float hi) { unsigned r; asm volatile("v_cvt_pk_bf16_f32 %0, %1, %2" : "=v"(r) : "v"(lo), "v"(hi)); return r; }
__device__ __forceinline__ float bf_lo(unsigned u) { return __uint_as_float(u << 16); }
__device__ __forceinline__ float bf_hi(unsigned u) { return __uint_as_float(u & 0xffff0000u); }

__device__ __forceinline__ float sum_xor16(float v) { auto r = __builtin_amdgcn_permlane16_swap(__float_as_uint(v), __float_as_uint(v), false, false); return __uint_as_float(r[0]) + __uint_as_float(r[1]); }
__device__ __forceinline__ float sum_xor32(float v) { auto r = __builtin_amdgcn_permlane32_swap(__float_as_uint(v), __float_as_uint(v), false, false); return __uint_as_float(r[0]) + __uint_as_float(r[1]); }
template <int CTRL> __device__ __forceinline__ float dpp_f(float v) { return __uint_as_float((unsigned)__builtin_amdgcn_update_dpp(0, (int)__float_as_uint(v), CTRL, 0xf, 0xf, true)); }
__device__ __forceinline__ float row16_sum(float v) { v += dpp_f<0x128>(v); v += dpp_f<0x124>(v); v += dpp_f<0x122>(v); v += dpp_f<0x121>(v); return v; }
__device__ __forceinline__ float wave_sum(float v) { return sum_xor32(sum_xor16(row16_sum(v))); }
__device__ __forceinline__ int opaque_tid() { int t = threadIdx.x; asm volatile("" : "+v"(t)); return t; }
__device__ __forceinline__ int vcu();
__device__ __forceinline__ float silu_f(float x) { return x / (1.0f + __expf(-x)); }

namespace pg8 {
constexpr int BM = 256, BK = 64, HALF = 128, HTB = HALF * BK * 2, STAGE_BYTES = 8 * HTB, NXCD = 8, WGM = 8;
__host__ __device__ __forceinline__ int lds_byte(int r, int c) { const int st = (r >> 4) * 2 + (c >> 5), rr = r & 15, cc = c & 31, ob = rr * 64 + cc * 2; return st * 1024 + (ob ^ (((ob >> 9) & 1) << 5)); }
__host__ __device__ __forceinline__ void stage_rc(int b, int& R, int& C) { const int st = b / 1024, sb = b % 1024, swz = sb ^ (((sb >> 9) & 1) << 5); R = (st >> 1) * 16 + swz / 64; C = (st & 1) * 32 + (swz % 64) / 2; }
__host__ __device__ __forceinline__ int perm32(int rho) { const int n = rho >> 4, i = rho & 15; return 8 * (i >> 2) + 4 * n + (i & 3); }

struct Unit { int pm, pn; };
struct Gemm { const bf16_t* A; const bf16_t* Bt; int M, N, K; int lda; int acol; };

struct StaticOrder {
    int nM, nN, nwg, G, c;
    __device__ void init(int M, int N, int G_, int c_) { nM = M / BM; nN = N / BM; nwg = nM * nN; G = G_; c = c_; }
    __device__ bool next(int i, Unit& u) const {
        const long L = (long)i * G + c; if (L >= nwg) return false;
        int wgid = (int)L; { const int q = nwg / NXCD, r = nwg % NXCD, xcd = wgid % NXCD, off = wgid / NXCD; wgid = (xcd < r ? xcd * (q + 1) : r * (q + 1) + (xcd - r) * q) + off; }
        const int nig = WGM * nN, gid = wgid / nig, fm = gid * WGM, gsz = (nM - fm) < WGM ? (nM - fm) : WGM;
        u.pm = fm + ((wgid % nig) % gsz); u.pn = (wgid % nig) / gsz; return true;
    }
};

struct EpiBf16 {
    static constexpr bool PERM = true, AFTER_DRAIN = false;
    bf16_t* O; int ldc;
    __device__ __forceinline__ void operator()(const f32x4 (&acc)[2][2][4][2], const Unit& u, int wr, int wc, int fr, int fq, LAS unsigned char* lds) const {
        const int row0 = u.pm * BM + wr * 64 + fr; const int col0 = u.pn * BM + wc * 32 + 8 * fq;
#pragma unroll
        for (int ai = 0; ai < 2; ++ai)
#pragma unroll
            for (int m = 0; m < 4; ++m) { bf16_t* rowp = O + (size_t)(row0 + ai * HALF + m * 16) * ldc + col0;
#pragma unroll
                for (int bj = 0; bj < 2; ++bj) { const f32x4 v0 = acc[ai][bj][m][0], v1 = acc[ai][bj][m][1];
                    u32x4 w; w.x = cvt_pk_bf16(v0[0], v0[1]); w.y = cvt_pk_bf16(v0[2], v0[3]); w.z = cvt_pk_bf16(v1[0], v1[1]); w.w = cvt_pk_bf16(v1[2], v1[3]);
                    *(u32x4*)(rowp + bj * HALF) = w; } }
    }
};

template <int KIND, bool SMP>
__device__ __forceinline__ void qkv_body(const f32x4 (&acc)[2][2][4][2], const LAS float* XS, bf16_t* dst, int dstride, float* onew, int rl0, int ntok0, int a, f32x4 g1, f32x4 g2, f32x4 inv) {
#pragma unroll
    for (int ai = 0; ai < 2; ++ai)
#pragma unroll
        for (int m = 0; m < 4; ++m) { const int rl = ai * HALF + rl0 + m * 16;
            f32x4 cs, sn;
            if (SMP && KIND < 2) { const int ntok = ntok0 + rl; const float pos = (float)(a == 0 ? (ntok >> 6) : (ntok & 63));
#pragma unroll
                for (int j = 0; j < 4; ++j) { const float rev = __builtin_amdgcn_fractf(pos * inv[j]); sn[j] = __builtin_amdgcn_sinf(rev); cs[j] = __builtin_amdgcn_cosf(rev); } }
#pragma unroll
            for (int bj = 0; bj < 2; ++bj) { f32x4 o1 = acc[ai][bj][m][0], o2 = acc[ai][bj][m][1];
                if (KIND < 2) { const f32x4 ps = *(const LAS f32x4*)(XS + (rl * 2 + bj) * 4); const float rs = __builtin_amdgcn_rsqf(((ps[0] + ps[1]) + (ps[2] + ps[3])) * (1.0f / 128.0f) + 1e-6f);
                    const f32x4 y1 = o1 * rs * g1, y2 = o2 * rs * g2;
                    if (SMP) { o1 = y1 * cs - y2 * sn; o2 = y2 * cs + y1 * sn; } else { o1 = y1; o2 = y2; } }
                u32x2 w1, w2; w1.x = cvt_pk_bf16(o1[0], o1[1]); w1.y = cvt_pk_bf16(o1[2], o1[3]); w2.x = cvt_pk_bf16(o2[0], o2[1]); w2.y = cvt_pk_bf16(o2[2], o2[3]);
                bf16_t* d = dst + rl * dstride + bj * 128; *(u32x2*)d = w1; *(u32x2*)(d + 32) = w2;
                if (KIND > 0 && !SMP) { float* o = onew + rl * 256 + bj * 128; *(f32x4*)o = o1; *(f32x4*)(o + 32) = o2; }
            }
            asm volatile("" ::: "memory"); __builtin_amdgcn_sched_barrier(0);
        }
}
struct EpiQKV {
    static constexpr bool PERM = true, AFTER_DRAIN = false;
    int al;
    __device__ __forceinline__ void operator()(const f32x4 (&acc)[2][2][4][2], const Unit& u, int wr, int wc, int fr, int fq, LAS unsigned char* lds) const {
        const Params kp = kparams();
        LAS float* XS = (LAS float*)(lds + STAGE_BYTES);
        const int pn = u.pn, rowt = u.pm * BM, rl0 = wr * 64 + fr;
        if (pn < 5) {
#pragma unroll
            for (int ai = 0; ai < 2; ++ai)
#pragma unroll
                for (int m = 0; m < 4; ++m)
#pragma unroll
                    for (int bj = 0; bj < 2; ++bj) { const f32x4 a0 = acc[ai][bj][m][0], a1 = acc[ai][bj][m][1];
                        float s = ((a0[0] * a0[0] + a0[1] * a0[1]) + (a0[2] * a0[2] + a0[3] * a0[3])) + ((a1[0] * a1[0] + a1[1] * a1[1]) + (a1[2] * a1[2] + a1[3] * a1[3]));
                        s = sum_xor32(sum_xor16(s));
                        if (fq == 0) XS[((ai * HALF + rl0 + m * 16) * 2 + bj) * 4 + wc] = s; }
        }
        asm volatile("s_waitcnt lgkmcnt(0)" ::: "memory"); __builtin_amdgcn_s_barrier(); asm volatile("" ::: "memory");
        const bool smp = rowt >= 8192;
        const int a = wc >> 1, pp0 = 16 * (wc & 1) + 4 * fq, d0 = 64 * a + pp0;
        f32x4 g1 = (f32x4){1.f, 1.f, 1.f, 1.f}, g2 = g1, inv = g1;
        if (pn < 5) { const float* gq = kp.qk_gains + (size_t)(al * 2 + (pn < 4 ? 0 : 1)) * 128; g1 = *(const f32x4*)(gq + d0); g2 = *(const f32x4*)(gq + d0 + 32);
#pragma unroll
            for (int j = 0; j < 4; ++j) inv[j] = __builtin_amdgcn_exp2f(-(float)(pp0 + j) * (13.287712379549449f / 32.0f)) * 0.15915494309189535f; }
        const int ntok0 = (rowt - 8192) & 2047, bs = (rowt - 8192) >> 11;
        if (pn < 4) { bf16_t* dst = (bf16_t*)(kp.ws + WS_QKV) + (size_t)rowt * 1024 + 2 * pn * 128 + d0;
            if (smp) qkv_body<0, true>(acc, XS, dst, 1024, nullptr, rl0, ntok0, a, g1, g2, inv); else qkv_body<0, false>(acc, XS, dst, 1024, nullptr, rl0, ntok0, a, g1, g2, inv); }
        else { const bool isv = pn == 5;
            bf16_t* dst = smp ? (bf16_t*)(kp.ws + (isv ? WS_VS : WS_KS) + (size_t)al * KVS_LAYER) + ((size_t)bs * 2560 + ntok0) * 256 + d0 : (bf16_t*)(kp.ws + (isv ? WS_VP : WS_KP)) + (size_t)rowt * 256 + d0;
            float* onew = kp.out + (size_t)16384 * 1024 + (isv ? (size_t)32 * 2 * 256 * 256 : 0) + (size_t)((rowt >> 8) * 2 + al) * 65536 + d0;
            if (!isv) { if (smp) qkv_body<1, true>(acc, XS, dst, 256, onew, rl0, ntok0, a, g1, g2, inv); else qkv_body<1, false>(acc, XS, dst, 256, onew, rl0, ntok0, a, g1, g2, inv); }
            else { if (smp) qkv_body<2, true>(acc, XS, dst, 256, onew, rl0, ntok0, a, g1, g2, inv); else qkv_body<2, false>(acc, XS, dst, 256, onew, rl0, ntok0, a, g1, g2, inv); } }
    }
};
struct EpiSwiGLU {
    static constexpr bool PERM = true, AFTER_DRAIN = false;
    bf16_t* O;
    __device__ __forceinline__ void operator()(const f32x4 (&acc)[2][2][4][2], const Unit& u, int wr, int wc, int fr, int fq, LAS unsigned char* lds) const {
        const int row0 = u.pm * BM + wr * 64 + fr; const int col0 = u.pn * 128 + wc * 16 + 4 * fq;
#pragma unroll
        for (int ai = 0; ai < 2; ++ai)
#pragma unroll
            for (int m = 0; m < 4; ++m) { bf16_t* rowp = O + (size_t)(row0 + ai * HALF + m * 16) * DFF + col0;
#pragma unroll
                for (int bj = 0; bj < 2; ++bj) { const f32x4 g = acc[ai][bj][m][0], up = acc[ai][bj][m][1]; f32x4 v;
#pragma unroll
                    for (int j = 0; j < 4; ++j) v[j] = g[j] * __builtin_amdgcn_rcpf(1.0f + __builtin_amdgcn_exp2f(-1.4426950408889634f * g[j])) * up[j];
                    u32x2 w; w.x = cvt_pk_bf16(v[0], v[1]); w.y = cvt_pk_bf16(v[2], v[3]);
                    *(u32x2*)(rowp + bj * 64) = w; } }
    }
};
struct EpiF32 {
    static constexpr bool PERM = false, AFTER_DRAIN = false;
    float* O; int ldc; const float* colscale;
    __device__ __forceinline__ void operator()(const f32x4 (&acc)[2][2][4][2], const Unit& u, int wr, int wc, int fr, int fq, LAS unsigned char* lds) const {
        const int row0 = u.pm * BM + wr * 64 + fr; const int col0 = u.pn * BM + wc * 32 + 4 * fq;
#pragma unroll
        for (int bj = 0; bj < 2; ++bj)
#pragma unroll
            for (int n = 0; n < 2; ++n) { const int col = col0 + bj * HALF + n * 16;
                const f32x4 sc = colscale ? *(const f32x4*)(colscale + col) : (f32x4){1.f, 1.f, 1.f, 1.f};
#pragma unroll
                for (int ai = 0; ai < 2; ++ai)
#pragma unroll
                    for (int m = 0; m < 4; ++m) *(f32x4*)(O + (size_t)(row0 + ai * HALF + m * 16) * ldc + col) = acc[ai][bj][m][n] * sc; }
    }
};

struct PanelSS {
    unsigned long long* gran;
    unsigned tag;
    __device__ __forceinline__ void run(const float (&part)[2][4], const Unit& u, int wr, int wc, int fr, int fq, LAS unsigned char* lds, int wid, int lane) const {
        LAS float* P = (LAS float*)lds;
        LAS float* S = (LAS float*)(lds + 4096);
#pragma unroll
        for (int ai = 0; ai < 2; ++ai)
#pragma unroll
            for (int m = 0; m < 4; ++m) { float s = part[ai][m]; s = sum_xor32(sum_xor16(s));
                if (fq == 0) P[(ai * HALF + wr * 64 + m * 16 + fr) * 4 + wc] = s; }
        asm volatile("s_waitcnt lgkmcnt(0)" ::: "memory"); __builtin_amdgcn_s_barrier(); asm volatile("" ::: "memory");
        const int row = wid * 32 + (lane & 31);
        unsigned long long* g = gran + (size_t)(u.pm * BM + row) * 4;
        if (lane < 32) { const float t = (P[row * 4 + 0] + P[row * 4 + 1]) + (P[row * 4 + 2] + P[row * 4 + 3]);
            __hip_atomic_store(g + u.pn, ((unsigned long long)tag << 32) | (unsigned long long)__float_as_uint(t), __ATOMIC_RELAXED, __HIP_MEMORY_SCOPE_AGENT); }
        float tot = 0.f;
        for (unsigned spins = 0;;) {
            bool ok = true; tot = 0.f;
            if (lane < 32) {
#pragma unroll
                for (int q = 0; q < 4; ++q) { const unsigned long long x = __hip_atomic_load(g + q, __ATOMIC_RELAXED, __HIP_MEMORY_SCOPE_AGENT); ok = ok && ((unsigned)(x >> 32) == tag); tot += __uint_as_float((unsigned)x); } }
            if (__all(ok)) break;
            if (++spins > (1u << 20)) break;
            __builtin_amdgcn_s_sleep(1);
        }
        if (lane < 32) S[row] = __builtin_amdgcn_rsqf(tot * (1.0f / 1024.0f) + 1e-6f);
        asm volatile("s_waitcnt lgkmcnt(0)" ::: "memory"); __builtin_amdgcn_s_barrier(); asm volatile("" ::: "memory");
    }
};
struct EpiFused {
    static constexpr bool PERM = true, AFTER_DRAIN = true;
    int l, stage; unsigned want;
    __device__ __forceinline__ void fused(f32x4 (&acc)[2][2][4][2], const Unit& u, int wr, int wc, int fr, int fq, LAS unsigned char* lds, int wid, int lane) const {
        const Params kp = kparams();
        const unsigned kf = want / 32u - 1u, rb = (kf >= 3u && kf <= 6u) ? 1u : 0u, wb = (kf >= 2u && kf <= 5u) ? 1u : 0u;
        const bf16_t* X16 = (const bf16_t*)(kp.ws + WS_X16 + rb * X16_COPY); bf16_t* X16w = (bf16_t*)(kp.ws + WS_X16 + wb * X16_COPY); const float* mod = (const float*)(kp.ws + WS_MOD);
        const float* colscale = (stage == 0 && (l & 1)) ? kp.pool_scale + (size_t)(l >> 1) * 1024 : nullptr;
        const int ln = stage == 0 ? l : (l < 3 ? l + 1 : 3);
        const float* modg = mod + (size_t)l * 5 * 6144; const int gate_idx = stage == 0 ? 2 : 5; const float* g_post = kp.norm_gains + (size_t)(l * 4 + (stage == 0 ? 1 : 3)) * 1024;
        const float* modh = mod + (size_t)ln * 5 * 6144; const int shift_idx = stage == 0 ? 3 : 0; const float* g_pre = kp.norm_gains + (size_t)(ln * 4 + (stage == 0 ? 2 : 0)) * 1024;
        const bool last = (stage == 1 && l == 3);
        const PanelSS st1{(unsigned long long*)(kp.ws + WS_XB1), 2u * kf + 1u}, st2{(unsigned long long*)(kp.ws + WS_XB2), 2u * kf + 2u};
        const LAS float* S = (const LAS float*)(lds + 4096);
        const int col0 = u.pn * BM + wc * 32 + 8 * fq, rowt = u.pm * BM;
        const int cond = rowt < 8192 ? 0 : 1 + ((rowt - 8192) >> 11);
        u32x4 pre[2][4][2];
#pragma unroll
        for (int m = 0; m < 4; ++m) { const bf16_t* xr = X16 + (size_t)(rowt + wr * 64 + m * 16 + fr) * 1024 + col0;
#pragma unroll
            for (int bj = 0; bj < 2; ++bj) pre[0][m][bj] = *(const u32x4*)(xr + bj * HALF); }
        if (colscale) {
#pragma unroll
            for (int bj = 0; bj < 2; ++bj)
#pragma unroll
                for (int n = 0; n < 2; ++n) { const f32x4 sc = *(const f32x4*)(colscale + col0 + bj * HALF + n * 4);
#pragma unroll
                    for (int ai = 0; ai < 2; ++ai)
#pragma unroll
                        for (int m = 0; m < 4; ++m) acc[ai][bj][m][n] *= sc; }
        }
        float part[2][4];
#pragma unroll
        for (int ai = 0; ai < 2; ++ai)
#pragma unroll
            for (int m = 0; m < 4; ++m) { float s = 0.f;
#pragma unroll
                for (int bj = 0; bj < 2; ++bj)
#pragma unroll
                    for (int n = 0; n < 2; ++n) { const f32x4 v = acc[ai][bj][m][n]; s += (v[0] * v[0] + v[1] * v[1]) + (v[2] * v[2] + v[3] * v[3]); }
                part[ai][m] = s; }
        st1.run(part, u, wr, wc, fr, fq, lds, wid, lane);
#pragma unroll
        for (int m = 0; m < 4; ++m) { const bf16_t* xr = X16 + (size_t)(rowt + HALF + wr * 64 + m * 16 + fr) * 1024 + col0;
#pragma unroll
            for (int bj = 0; bj < 2; ++bj) pre[1][m][bj] = *(const u32x4*)(xr + bj * HALF); }
        {
            f32x4 Gv[2][2];
#pragma unroll
            for (int bj = 0; bj < 2; ++bj)
#pragma unroll
                for (int n = 0; n < 2; ++n) { const int col = col0 + bj * HALF + n * 4;
                    Gv[bj][n] = *(const f32x4*)(modg + (size_t)cond * 6144 + gate_idx * 1024 + col) * *(const f32x4*)(g_post + col); }
#pragma unroll
            for (int ai = 0; ai < 2; ++ai)
#pragma unroll
                for (int m = 0; m < 4; ++m) { const float rs = S[ai * HALF + wr * 64 + m * 16 + fr];
#pragma unroll
                    for (int bj = 0; bj < 2; ++bj) { const u32x4 xp = pre[ai][m][bj];
                        const f32x4 xv0 = (f32x4){bf_lo(xp.x), bf_hi(xp.x), bf_lo(xp.y), bf_hi(xp.y)}, xv1 = (f32x4){bf_lo(xp.z), bf_hi(xp.z), bf_lo(xp.w), bf_hi(xp.w)};
                        acc[ai][bj][m][0] = xv0 + Gv[bj][0] * (acc[ai][bj][m][0] * rs); acc[ai][bj][m][1] = xv1 + Gv[bj][1] * (acc[ai][bj][m][1] * rs); } }
        }
        if (!last) {
#pragma unroll
            for (int ai = 0; ai < 2; ++ai)
#pragma unroll
                for (int m = 0; m < 4; ++m) { float s = 0.f;
#pragma unroll
                    for (int bj = 0; bj < 2; ++bj)
#pragma unroll
                        for (int n = 0; n < 2; ++n) { const f32x4 v = acc[ai][bj][m][n]; s += (v[0] * v[0] + v[1] * v[1]) + (v[2] * v[2] + v[3] * v[3]); }
                    part[ai][m] = s; }
            st2.run(part, u, wr, wc, fr, fq, lds, wid, lane);
            asm volatile("" : "+v"(fr), "+v"(fq));
            const int col0 = u.pn * BM + wc * 32 + 8 * fq;
            if (stage == 1 && (l & 1) == 0 && gridDim.x == 256) {
                if (u.pn == 0 && lane < 32) ((float*)(kp.ws + WS_RS))[rowt + wid * 32 + lane] = S[wid * 32 + lane];
#pragma unroll
                for (int ai = 0; ai < 2; ++ai)
#pragma unroll
                    for (int m = 0; m < 4; ++m) { const size_t off = (size_t)(rowt + ai * HALF + wr * 64 + m * 16 + fr) * 1024 + col0;
#pragma unroll
                        for (int bj = 0; bj < 2; ++bj) { const f32x4 x0 = acc[ai][bj][m][0], x1 = acc[ai][bj][m][1];
                            u32x4 xw; xw.x = cvt_pk_bf16(x0[0], x0[1]); xw.y = cvt_pk_bf16(x0[2], x0[3]); xw.z = cvt_pk_bf16(x1[0], x1[1]); xw.w = cvt_pk_bf16(x1[2], x1[3]);
                            *(u32x4*)(X16w + off + bj * HALF) = xw; } }
                return;
            }
            bf16_t* H = (bf16_t*)(kp.ws + WS_H);
            f32x4 Av[2][2], Bv[2][2];
#pragma unroll
            for (int bj = 0; bj < 2; ++bj)
#pragma unroll
                for (int n = 0; n < 2; ++n) { const int col = col0 + bj * HALF + n * 4;
                    Av[bj][n] = *(const f32x4*)(g_pre + col) * (*(const f32x4*)(modh + (size_t)cond * 6144 + (shift_idx + 1) * 1024 + col) + 1.0f);
                    Bv[bj][n] = *(const f32x4*)(modh + (size_t)cond * 6144 + shift_idx * 1024 + col); }
#pragma unroll
            for (int ai = 0; ai < 2; ++ai)
#pragma unroll
                for (int m = 0; m < 4; ++m) { const int r = ai * HALF + wr * 64 + m * 16 + fr; const float rs = S[r]; const size_t off = (size_t)(rowt + r) * 1024 + col0;
#pragma unroll
                    for (int bj = 0; bj < 2; ++bj) { const f32x4 x0 = acc[ai][bj][m][0], x1 = acc[ai][bj][m][1];
                        u32x4 xw; xw.x = cvt_pk_bf16(x0[0], x0[1]); xw.y = cvt_pk_bf16(x0[2], x0[3]); xw.z = cvt_pk_bf16(x1[0], x1[1]); xw.w = cvt_pk_bf16(x1[2], x1[3]);
                        *(u32x4*)(X16w + off + bj * HALF) = xw;
                        const f32x4 h0 = (x0 * rs) * Av[bj][0] + Bv[bj][0], h1 = (x1 * rs) * Av[bj][1] + Bv[bj][1];
                        u32x4 w; w.x = cvt_pk_bf16(h0[0], h0[1]); w.y = cvt_pk_bf16(h0[2], h0[3]); w.z = cvt_pk_bf16(h1[0], h1[1]); w.w = cvt_pk_bf16(h1[2], h1[3]);
                        *(u32x4*)(H + off + bj * HALF) = w; }
                    asm volatile("" ::: "memory"); }
        } else {
            float* X = kp.out;
#pragma unroll
            for (int ai = 0; ai < 2; ++ai)
#pragma unroll
                for (int m = 0; m < 4; ++m) { const size_t off = (size_t)(rowt + ai * HALF + wr * 64 + m * 16 + fr) * 1024 + col0;
#pragma unroll
                    for (int bj = 0; bj < 2; ++bj)
#pragma unroll
                        for (int n = 0; n < 2; ++n) *(f32x4*)(X + off + bj * HALF + n * 4) = acc[ai][bj][m][n]; }
        }
    }
};

template <class Epi, class Sched, bool ALIGN_EPI>
__device__ __forceinline__ void gemm_phase(LAS unsigned char* lds, const Gemm g, const Sched& S, const Epi& E) {
    const int tid = opaque_tid(), wid = __builtin_amdgcn_readfirstlane(tid >> 6), lane = tid & 63, wr = wid >> 2, wc = wid & 3, fr = lane & 15, fq = lane >> 4;
    const int K = g.K, nt = K / BK, lda = g.lda;
    unsigned voffA[2], voffB[2];
#pragma unroll
    for (int i = 0; i < 2; ++i) { int R, C; stage_rc(tid * 16 + i * 8192, R, C); const int Rb = Epi::PERM ? ((R & ~31) + perm32(R & 31)) : R;
        voffA[i] = (unsigned)(R * lda + C) * 2u; voffB[i] = (unsigned)(Rb * K + C) * 2u; }
    const size_t kstep = (size_t)(BK * 2);
    const size_t hA = (size_t)HALF * lda * 2, hB = (size_t)HALF * K * 2;
    const size_t tA = 2 * hA, tB = 2 * hB;
    const size_t acolB = (size_t)g.acol * 2;
    const unsigned ldsw = (unsigned)wid * 1024u;
    const int aoff = lds_byte(wr * 64 + fr, fq * 8), boff = lds_byte(wc * 32 + fr, fq * 8);
#define PG8_SA(b, h) (((b) * 2 + (h)) * HTB)
#define PG8_SB(b, h) ((4 + (b) * 2 + (h)) * HTB)
#define PG8_STAGE(bufoff, gbase, voff) do { _Pragma("unroll") for (int _i = 0; _i < 2; ++_i) \
        __builtin_amdgcn_global_load_lds((const unsigned*)((const char*)(gbase) + (voff)[_i]), (LAS unsigned*)(lds + (bufoff) + ldsw + _i * 8192), 16, 0, 0); } while (0)
#define PG8_LDA(dst, b, h) do { _Pragma("unroll") for (int m = 0; m < 4; ++m) _Pragma("unroll") for (int k = 0; k < 2; ++k) dst[m][k] = *(const LAS bf16x8*)(lds + PG8_SA(b, h) + aoff + m * 2048 + k * 1024); } while (0)
#define PG8_LDB(dst, b, h) do { _Pragma("unroll") for (int n = 0; n < 2; ++n) _Pragma("unroll") for (int k = 0; k < 2; ++k) dst[n][k] = *(const LAS bf16x8*)(lds + PG8_SB(b, h) + boff + n * 2048 + k * 1024); } while (0)
#define PG8_MMA(ai, bj, At, Bt) do { __builtin_amdgcn_s_setprio(1); _Pragma("unroll") for (int m = 0; m < 4; ++m) _Pragma("unroll") for (int n = 0; n < 2; ++n) _Pragma("unroll") for (int k = 0; k < 2; ++k) \
        acc[ai][bj][m][n] = __builtin_amdgcn_mfma_f32_16x16x32_bf16(Bt[n][k], At[m][k], acc[ai][bj][m][n], 0, 0, 0); __builtin_amdgcn_s_setprio(0); } while (0)
#define PG8_WAIT_V(n) asm volatile("s_waitcnt vmcnt(" #n ")" ::: "memory")
#define PG8_WAIT_L(n) asm volatile("s_waitcnt lgkmcnt(" #n ")" ::: "memory")
#define PG8_BAR __builtin_amdgcn_s_barrier()
#define PG8_SCHED __builtin_amdgcn_sched_barrier(0)
    Unit cur, nxt; int ui = 0;
    if (!S.next(0, cur)) return;
    f32x4 acc[2][2][4][2];
#pragma unroll
    for (int a = 0; a < 2; ++a)
#pragma unroll
        for (int b = 0; b < 2; ++b)
#pragma unroll
            for (int m = 0; m < 4; ++m)
#pragma unroll
                for (int n = 0; n < 2; ++n) acc[a][b][m][n] = (f32x4){0.f, 0.f, 0.f, 0.f};
    bf16x8 At[4][2], B0[2][2], B1[2][2];
    const char* cA = (const char*)g.A + (size_t)cur.pm * tA + (size_t)cur.pn * acolB; const char* cB = (const char*)g.Bt + (size_t)cur.pn * tB;
    PG8_STAGE(PG8_SB(0, 0), cB, voffB); PG8_STAGE(PG8_SB(0, 1), cB + hB, voffB); PG8_STAGE(PG8_SA(0, 0), cA, voffA); PG8_STAGE(PG8_SA(0, 1), cA + hA, voffA);
    if (wr == 1) PG8_BAR;
    PG8_WAIT_V(2); PG8_BAR;
    PG8_STAGE(PG8_SB(1, 0), cB + kstep, voffB); PG8_STAGE(PG8_SA(1, 0), cA + kstep, voffA); PG8_STAGE(PG8_SB(1, 1), cB + hB + kstep, voffB);
    PG8_WAIT_V(6); PG8_BAR;
    for (;;) {
        const bool has_next = S.next(ui + 1, nxt);
        const char* nA = has_next ? (const char*)g.A + (size_t)nxt.pm * tA + (size_t)nxt.pn * acolB : cA; const char* nB = has_next ? (const char*)g.Bt + (size_t)nxt.pn * tB : cB;
        for (int t = 0; t < nt; t += 2) {
            const bool last = (t == nt - 2);
            const char* a1 = cA + (size_t)(t + 1) * kstep;
            const char* a2 = last ? nA : cA + (size_t)(t + 2) * kstep; const char* b2 = last ? nB : cB + (size_t)(t + 2) * kstep;
            const char* a3 = a2 + kstep; const char* b3 = b2 + kstep;
            PG8_LDB(B0, 0, 0); PG8_LDB(B1, 0, 1); PG8_SCHED; PG8_LDA(At, 0, 0); PG8_STAGE(PG8_SA(1, 1), a1 + hA, voffA);
            PG8_WAIT_V(8); PG8_WAIT_L(0); PG8_BAR; PG8_MMA(0, 0, At, B0); PG8_MMA(0, 1, At, B1); PG8_BAR; PG8_SCHED;
            PG8_LDA(At, 0, 1); PG8_STAGE(PG8_SB(0, 0), b2, voffB); PG8_STAGE(PG8_SB(0, 1), b2 + hB, voffB); PG8_STAGE(PG8_SA(0, 0), a2, voffA);
            PG8_WAIT_V(8); PG8_WAIT_L(0); PG8_BAR; PG8_MMA(1, 0, At, B0); PG8_MMA(1, 1, At, B1); PG8_BAR; PG8_SCHED;
            PG8_LDB(B0, 1, 0); PG8_LDB(B1, 1, 1); PG8_SCHED; PG8_LDA(At, 1, 0); PG8_STAGE(PG8_SA(0, 1), a2 + hA, voffA);
            PG8_WAIT_V(8); PG8_WAIT_L(0); PG8_BAR; PG8_MMA(0, 0, At, B0); PG8_MMA(0, 1, At, B1); PG8_BAR; PG8_SCHED;
            PG8_LDA(At, 1, 1); PG8_STAGE(PG8_SB(1, 0), b3, voffB); PG8_STAGE(PG8_SB(1, 1), b3 + hB, voffB); PG8_STAGE(PG8_SA(1, 0), a3, voffA);
            PG8_WAIT_V(8); PG8_WAIT_L(0); PG8_BAR; PG8_MMA(1, 0, At, B0); PG8_MMA(1, 1, At, B1); PG8_BAR; PG8_SCHED;
        }
        if constexpr (ALIGN_EPI) { if (wr == 0) PG8_BAR; }
        if constexpr (!Epi::AFTER_DRAIN) { int fr_ = fr, fq_ = fq, wr_ = wr, wc_ = wc; asm volatile("" : "+v"(fr_), "+v"(fq_), "+s"(wr_), "+s"(wc_)); E(acc, cur, wr_, wc_, fr_, fq_, lds); }
        if (!has_next) break;
#pragma unroll
        for (int a = 0; a < 2; ++a)
#pragma unroll
            for (int b = 0; b < 2; ++b)
#pragma unroll
                for (int m = 0; m < 4; ++m)
#pragma unroll
                    for (int n = 0; n < 2; ++n) acc[a][b][m][n] = (f32x4){0.f, 0.f, 0.f, 0.f};
        cur = nxt; cA = nA; cB = nB; ++ui;
        if constexpr (ALIGN_EPI) { if (wr == 1) PG8_BAR; }
    }
    PG8_WAIT_V(0);
    if constexpr (!ALIGN_EPI) { if (wr == 0) PG8_BAR; }
    PG8_BAR;
    if constexpr (Epi::AFTER_DRAIN) { int fr_ = fr, fq_ = fq, wr_ = wr, wc_ = wc; asm volatile("" : "+v"(fr_), "+v"(fq_), "+s"(wr_), "+s"(wc_)); E.fused(acc, cur, wr_, wc_, fr_, fq_, lds, wid, lane); }
#undef PG8_SA
#undef PG8_SB
#undef PG8_STAGE
#undef PG8_LDA
#undef PG8_LDB
#undef PG8_MMA
#undef PG8_WAIT_V
#undef PG8_WAIT_L
#undef PG8_BAR
#undef PG8_SCHED
}
}

namespace attn {
constexpr int D = 128, NW = 8, QBLK = 32, KVBLK = 64;
constexpr float SCALE = 0.088388347648318440f;
constexpr float THR = 8.f;
constexpr int LDQ = DM, LDK = KVW, LDO = DM;
constexpr size_t SHM_V = KVBLK * D * 2, SHM_K = KVBLK * D * 2, SHM_ATTN = 2 * SHM_V + 2 * SHM_K + NW * 64 * 4;
#define KSWZ(row, colB) ((row) * 256 + ((colB) ^ (((row) & 7) << 4)))
#define SBAR() __builtin_amdgcn_sched_barrier(0)
__device__ __forceinline__ int crow(int r, int hi) { return (r & 3) + 8 * (r >> 2) + 4 * hi; }
__device__ __forceinline__ unsigned cvtpk(float lo, float hi) { unsigned r; asm volatile("v_cvt_pk_bf16_f32 %0, %1, %2" : "=v"(r) : "v"(lo), "v"(hi)); return r; }
__device__ __forceinline__ void partialSM(f32x16& p0, f32x16& p1, float& m_reg, float& mn, float& alpha) {
  constexpr float C = SCALE * 1.4426950408889634f;
  float pmax = p0[0]; for (int r = 1; r < 16; ++r) pmax = fmaxf(pmax, p0[r]); for (int r = 0; r < 16; ++r) pmax = fmaxf(pmax, p1[r]);
  { auto rr = __builtin_amdgcn_permlane32_swap(__float_as_uint(pmax), __float_as_uint(pmax), false, false);
    pmax = fmaxf(__uint_as_float(rr[0]), __uint_as_float(rr[1])); }
  if (__builtin_expect(__all(pmax - m_reg <= THR / SCALE), 1)) { mn = m_reg; alpha = 1.f; }
  else { mn = fmaxf(m_reg, pmax); alpha = __builtin_amdgcn_exp2f((m_reg - mn) * C); m_reg = mn; }
  float mnC = -mn * C;
  for (int r = 0; r < 16; ++r) p0[r] = fmaf(p0[r], C, mnC); for (int r = 0; r < 16; ++r) p1[r] = fmaf(p1[r], C, mnC);
  for (int r = 0; r < 16; ++r) p0[r] = __builtin_amdgcn_exp2f(p0[r]);
}
__device__ __forceinline__ void finishSM(f32x16& p0, f32x16& p1, float alpha, float& l_reg, bf16x8& pa0, bf16x8& pa1, bf16x8& pa2, bf16x8& pa3) {
  for (int r = 0; r < 16; ++r) p1[r] = __builtin_amdgcn_exp2f(p1[r]);
  float ps = 0; for (int r = 0; r < 16; ++r) ps += p0[r]; for (int r = 0; r < 16; ++r) ps += p1[r];
  { auto rr = __builtin_amdgcn_permlane32_swap(__float_as_uint(ps), __float_as_uint(ps), false, false);
    ps = __uint_as_float(rr[0]) + __uint_as_float(rr[1]); }
  l_reg = l_reg * alpha + ps;
#define PK4(P, BASE, OUT) do { unsigned a0 = cvtpk(P[BASE + 0], P[BASE + 1]), a1 = cvtpk(P[BASE + 2], P[BASE + 3]);   \
    unsigned b0 = cvtpk(P[BASE + 4], P[BASE + 5]), b1 = cvtpk(P[BASE + 6], P[BASE + 7]);                              \
    auto r0 = __builtin_amdgcn_permlane32_swap(a0, b0, false, false); auto r1 = __builtin_amdgcn_permlane32_swap(a1, b1, false, false); \
    u32x4 w = {r0[0], r1[0], r0[1], r1[1]}; OUT = *reinterpret_cast<bf16x8*>(&w); } while (0)
  PK4(p0, 0, pa0); PK4(p0, 8, pa1); PK4(p1, 0, pa2); PK4(p1, 8, pa3);
#undef PK4
}
__device__ __forceinline__ void qkt(f32x16& p0, f32x16& p1, const bf16_t* Ks, const bf16x8* qr, int r32, int hi) {
  p0 = f32x16{}; p1 = f32x16{};
#pragma unroll
  for (int d0 = 0; d0 < 8; ++d0) { int cb = (d0 * 16 + hi * 8) * 2;
    bf16x8 b0 = *reinterpret_cast<const bf16x8*>((const char*)Ks + KSWZ(r32, cb));
    bf16x8 b1 = *reinterpret_cast<const bf16x8*>((const char*)Ks + KSWZ(32 + r32, cb));
    p0 = __builtin_amdgcn_mfma_f32_32x32x16_bf16(b0, qr[d0], p0, 0, 0, 0);
    p1 = __builtin_amdgcn_mfma_f32_32x32x16_bf16(b1, qr[d0], p1, 0, 0, 0); }
}
__device__ __forceinline__ int v_st(int k, int c) { const int kk = (k & ~0xC) | ((k & 4) << 1) | ((k & 8) >> 1); return ((kk >> 3) * 4 + (c >> 5)) * 512 + ((kk & 7) * 32 + (c & 31)) * 2; }
__device__ __forceinline__ int v_rd_base(int lane) { return ((lane & 3) << 3) | (((lane >> 2) & 3) << 6) | (((lane >> 4) & 1) << 5) | (((lane >> 5) & 1) << 8); }
constexpr int v_rd_off(int d0, int ks, int half) { return d0 * 512 + ks * 4096 + half * 2048; }
template <int OFF> __device__ __forceinline__ s16x4 tr_read(int vb) {
  s16x4 r; asm volatile("ds_read_b64_tr_b16 %0, %1 offset:%2" : "=&v"(r) : "v"(vb), "i"(OFF) : "memory"); return r;
}
template <int D0> __device__ __forceinline__ void pv_one(f32x16& od, int vb, bf16x8 pa0, bf16x8 pa1, bf16x8 pa2, bf16x8 pa3) {
  const s16x4 l0 = tr_read<v_rd_off(D0, 0, 0)>(vb), h0 = tr_read<v_rd_off(D0, 0, 1)>(vb), l1 = tr_read<v_rd_off(D0, 1, 0)>(vb), h1 = tr_read<v_rd_off(D0, 1, 1)>(vb);
  const s16x4 l2 = tr_read<v_rd_off(D0, 2, 0)>(vb), h2 = tr_read<v_rd_off(D0, 2, 1)>(vb), l3 = tr_read<v_rd_off(D0, 3, 0)>(vb), h3 = tr_read<v_rd_off(D0, 3, 1)>(vb);
  asm volatile("s_waitcnt lgkmcnt(0)" ::: "memory"); SBAR();
#define PK(L, H) (bf16x8){L[0], L[1], L[2], L[3], H[0], H[1], H[2], H[3]}
  od = __builtin_amdgcn_mfma_f32_32x32x16_bf16(pa0, PK(l0, h0), od, 0, 0, 0);
  od = __builtin_amdgcn_mfma_f32_32x32x16_bf16(pa1, PK(l1, h1), od, 0, 0, 0);
  od = __builtin_amdgcn_mfma_f32_32x32x16_bf16(pa2, PK(l2, h2), od, 0, 0, 0);
  od = __builtin_amdgcn_mfma_f32_32x32x16_bf16(pa3, PK(l3, h3), od, 0, 0, 0);
#undef PK
}
__device__ __forceinline__ void pv_d0(f32x16* o, int vb, bf16x8 pa0, bf16x8 pa1, bf16x8 pa2, bf16x8 pa3) {
  pv_one<0>(o[0], vb, pa0, pa1, pa2, pa3); pv_one<1>(o[1], vb, pa0, pa1, pa2, pa3); pv_one<2>(o[2], vb, pa0, pa1, pa2, pa3); pv_one<3>(o[3], vb, pa0, pa1, pa2, pa3);
}
__device__ __forceinline__ void attn_dense_body(const bf16_t* __restrict__ Qb, const bf16_t* __restrict__ Kh, const bf16_t* __restrict__ Vh,
                                                bf16_t* __restrict__ Ob, int seq, char* lds) {
  const int tid = opaque_tid(), wid = tid >> 6, lane = tid & 63, r32 = lane & 31, hi = lane >> 5;
  bf16_t* V_lds = (bf16_t*)lds; bf16_t* K_lds = (bf16_t*)(lds + 2 * SHM_V);
  float* ws = (float*)(lds + 2 * SHM_V + 2 * SHM_K) + wid * 64; float* li_l = ws; float* al_l = ws + 32;
  float m_reg = -1e30f, l_reg = 0; f32x16 o[4] = {}; bf16x8 qr[8];
  const bf16_t* Qw = Qb + (long)(wid * QBLK + r32) * LDQ + hi * 8;
#pragma unroll
  for (int d0 = 0; d0 < 8; ++d0) qr[d0] = *reinterpret_cast<const bf16x8*>(Qw + d0 * 16);
  const int sr = tid >> 4, sc = (tid & 15) * 8, vst0 = v_st(sr, sc), vst1 = v_st(32 + sr, sc);
  const int vb0 = (int)(uintptr_t)V_lds + v_rd_base(lane);
  struct { bf16x8 vs0, vs1, ks0, ks1; } sr_[2];
#define SLOAD(i, k0) do { sr_[i].vs0 = *reinterpret_cast<const bf16x8*>(&Vh[(long)((k0) + sr) * LDK + sc]); sr_[i].vs1 = *reinterpret_cast<const bf16x8*>(&Vh[(long)((k0) + 32 + sr) * LDK + sc]); \
    sr_[i].ks0 = *reinterpret_cast<const bf16x8*>(&Kh[(long)((k0) + sr) * LDK + sc]); sr_[i].ks1 = *reinterpret_cast<const bf16x8*>(&Kh[(long)((k0) + 32 + sr) * LDK + sc]); } while (0)
#define SWRITE(b, i) do { *(bf16x8*)((char*)V_lds + (b) * SHM_V + vst0) = sr_[i].vs0;          \
    *(bf16x8*)((char*)V_lds + (b) * SHM_V + vst1) = sr_[i].vs1; int kc = sc * 2;               \
    *(bf16x8*)((char*)K_lds + (b) * SHM_K + KSWZ(sr, kc)) = sr_[i].ks0;                       \
    *(bf16x8*)((char*)K_lds + (b) * SHM_K + KSWZ(32 + sr, kc)) = sr_[i].ks1; } while (0)
#define SWAIT() asm volatile("s_waitcnt vmcnt(4)" ::: "memory")
#define RESC(a) do { if (__any((a) < 1.f)) { if (hi == 0) al_l[r32] = (a); asm volatile("s_waitcnt lgkmcnt(0)" ::: "memory"); \
    for (int d = 0; d < 4; ++d) for (int r = 0; r < 16; ++r) o[d][r] *= al_l[crow(r, hi)]; } } while (0)
  f32x16 pA0, pA1, pB0, pB1; float mnA, mnB, alA, alB; bf16x8 pa0, pa1, pa2, pa3; const int NT = seq / KVBLK;
  constexpr int SE = 0, SO = 1;
  SLOAD(SE, 0); asm volatile("s_waitcnt vmcnt(0)" ::: "memory"); SWRITE(0, SE); __syncthreads();
  qkt(pA0, pA1, K_lds, qr, r32, hi); partialSM(pA0, pA1, m_reg, mnA, alA);
  SLOAD(SO, KVBLK); if (2 < NT) SLOAD(SE, 2 * KVBLK);
  SWAIT(); SWRITE(1, SO); __syncthreads();
  for (int j = 1; j + 1 < NT; j += 2) {
    SBAR(); qkt(pB0, pB1, (bf16_t*)((char*)K_lds + SHM_K), qr, r32, hi);
    finishSM(pA0, pA1, alA, l_reg, pa0, pa1, pa2, pa3); SBAR();
    SLOAD(SO, (j + 2) * KVBLK); SBAR();
    pv_d0(o, vb0, pa0, pa1, pa2, pa3); partialSM(pB0, pB1, m_reg, mnB, alB);
    __syncthreads(); SWAIT(); SWRITE(0, SE);
    RESC(alB); __syncthreads();
    SBAR(); qkt(pA0, pA1, K_lds, qr, r32, hi);
    finishSM(pB0, pB1, alB, l_reg, pa0, pa1, pa2, pa3); SBAR();
    if (j + 3 < NT) SLOAD(SE, (j + 3) * KVBLK); SBAR();
    pv_d0(o, vb0 + (int)SHM_V, pa0, pa1, pa2, pa3); partialSM(pA0, pA1, m_reg, mnA, alA);
    __syncthreads(); SWAIT(); SWRITE(1, SO);
    RESC(alA); __syncthreads();
  }
  SBAR(); qkt(pB0, pB1, (bf16_t*)((char*)K_lds + SHM_K), qr, r32, hi);
  finishSM(pA0, pA1, alA, l_reg, pa0, pa1, pa2, pa3); SBAR();
  pv_d0(o, vb0, pa0, pa1, pa2, pa3); partialSM(pB0, pB1, m_reg, mnB, alB);
  __syncthreads(); RESC(alB);
  finishSM(pB0, pB1, alB, l_reg, pa0, pa1, pa2, pa3); SBAR();
  pv_d0(o, vb0 + (int)SHM_V, pa0, pa1, pa2, pa3);
  if (hi == 0) li_l[r32] = l_reg; asm volatile("s_waitcnt lgkmcnt(0)" ::: "memory");
  float rli[16];
#pragma unroll
  for (int r = 0; r < 16; ++r) rli[r] = __builtin_amdgcn_rcpf(li_l[crow(r, hi)]);
  bf16_t* Ow = Ob + (long)(wid * QBLK) * LDO;
#pragma unroll
  for (int r = 0; r < 16; ++r) { int orow = crow(r, hi);
#pragma unroll
    for (int d0 = 0; d0 < 4; ++d0) { const float v = o[d0][r] * rli[r]; Ow[(long)orow * LDO + d0 * 32 + r32] = (bf16_t)(cvtpk(v, v) & 0xffffu); } }
#undef SLOAD
#undef SWRITE
#undef SWAIT
#undef RESC
}
}

__device__ __forceinline__ int up_row(int n) { const int n2 = n >= DFF ? n - DFF : n; return 8 * (n2 >> 2) + (n2 & 3) + (n >= DFF ? 4 : 0); }
__device__ __forceinline__ int qkv_row(int n) { const int d = n & 127, a = d >> 6, nn = (d >> 5) & 1, pp = d & 31; return (n & ~127) + 8 * ((32 * a + pp) >> 2) + 4 * nn + (pp & 3); }
__device__ __forceinline__ void transpose_item(const float* W, int K, int N, bf16_t* WT, int rmap, LAS float* scr, int item, int lane) {
    const int nblk = N / 32, kb = item / nblk, nb = item % nblk, k0 = 64 * kb, n0 = 32 * nb;
    float tv[32];
    const float* wp = W + (size_t)(k0 + (lane >> 5)) * N + n0 + (lane & 31);
#pragma unroll
    for (int i = 0; i < 32; ++i) tv[i] = wp[(size_t)(2 * i) * N];
#pragma unroll
    for (int i = 0; i < 32; ++i) scr[(2 * i + (lane >> 5)) * 33 + (lane & 31)] = tv[i];
    asm volatile("s_waitcnt lgkmcnt(0)" ::: "memory");
    const int c = lane & 7;
#pragma unroll
    for (int j = 0; j < 4; ++j) { const int n = (lane >> 3) + 8 * j; const LAS float* s = scr + (8 * c) * 33 + n;
        u32x4 o; o.x = cvt_pk_bf16(s[0 * 33], s[1 * 33]); o.y = cvt_pk_bf16(s[2 * 33], s[3 * 33]); o.z = cvt_pk_bf16(s[4 * 33], s[5 * 33]); o.w = cvt_pk_bf16(s[6 * 33], s[7 * 33]);
        const int dr = rmap == 1 ? up_row(n0 + n) : (rmap == 2 ? qkv_row(n0 + n) : (n0 + n));
        *(u32x4*)(WT + (size_t)dr * K + k0 + 8 * c) = o; }
    asm volatile("s_waitcnt lgkmcnt(0)" ::: "memory");
}

__device__ __forceinline__ void convert_layer_weights(int l, int widx, int nw, LAS unsigned char* lds) {
    const Params p = kparams(); unsigned char* ws = p.ws;
    const int tid = opaque_tid(), lane = tid & 63, wave = __builtin_amdgcn_readfirstlane(tid >> 6);
    LAS float* scr = (LAS float*)(lds + 65536 + wave * 8704);
    constexpr int I_QKV = 16 * 48, I_O = 16 * 32, I_PL = 4 * 8, I_UP = 16 * 176, I_DN = 44 * 32;
    const int nmix = (l & 1) ? 4 * I_PL : I_QKV + I_O, nitems = I_UP + I_DN + nmix, a = l >> 1;
    for (int it = widx; it < nitems; it += nw) {
        int r = it; const float* W; bf16_t* WT; int K, N, sub; int upm = 0;
        if (r < I_UP) { sub = r; W = p.w_up + (size_t)l * DM * 2 * DFF; K = DM; N = 2 * DFF; WT = (bf16_t*)(ws + WS_WUP) + (size_t)l * 2 * DFF * DM; upm = 1; }
        else if ((r -= I_UP) < I_DN) { sub = r; W = p.w_down + (size_t)l * DFF * DM; K = DFF; N = DM; WT = (bf16_t*)(ws + WS_WDN) + (size_t)l * DM * DFF; }
        else if (l & 1) { r -= I_DN; const int pg = a * 4 + r / I_PL; sub = r % I_PL; W = p.w_pool + (size_t)pg * 65536; K = 256; N = 256; WT = (bf16_t*)(ws + WS_WPOOL) + (size_t)pg * 65536; }
        else if ((r -= I_DN) < I_QKV) { sub = r; W = p.w_qkv + (size_t)a * DM * QKVW; K = DM; N = QKVW; WT = (bf16_t*)(ws + WS_WQKV) + (size_t)a * QKVW * DM; upm = 2; }
        else { sub = r - I_QKV; W = p.w_o + (size_t)a * DM * DM; K = DM; N = DM; WT = (bf16_t*)(ws + WS_WO) + (size_t)a * DM * DM; }
        transpose_item(W, K, N, WT, upm, scr, sub, lane);
    }
}

__device__ __forceinline__ void mod_items(int item_begin, int item_end, int bidx, int nblk, LAS unsigned char* lds) {
    const Params p = kparams();
    const int tid = opaque_tid();
    LAS float* sil = (LAS float*)lds;
    LAS float* red = (LAS float*)(lds + 20480);
    if (item_begin + bidx >= item_end) return;
    for (int i = tid; i < 5 * DM; i += 512) { const int cnd = i >> 10, k = i & 1023; const float v = cnd == 0 ? p.c_ctx[k] : p.c[(cnd - 1) * DM + k]; sil[i] = silu_f(v); }
    __syncthreads();
    float* modo = (float*)(p.ws + WS_MOD);
    for (int item = item_begin + bidx; item < item_end; item += nblk) {
        const int l = item / 192, col0 = (item % 192) * 32, cgp = tid & 7, kr = tid >> 3;
        f32x4 acc[5];
#pragma unroll
        for (int cnd = 0; cnd < 5; ++cnd) acc[cnd] = (f32x4){0.f, 0.f, 0.f, 0.f};
        const float* wp = p.w_ada + ((size_t)l * DM + kr) * NMODW + col0 + 4 * cgp;
        f32x4 w4[16];
#pragma unroll
        for (int i = 0; i < 16; ++i) w4[i] = *(const f32x4*)(wp + (size_t)i * 64 * NMODW);
#pragma unroll
        for (int i = 0; i < 16; ++i) { const int k = kr + 64 * i;
#pragma unroll
            for (int cnd = 0; cnd < 5; ++cnd) acc[cnd] += w4[i] * sil[cnd * DM + k]; }
#pragma unroll
        for (int cnd = 0; cnd < 5; ++cnd) *(LAS f32x4*)(red + (kr * 5 + cnd) * 32 + 4 * cgp) = acc[cnd];
        __syncthreads();
        if (tid < 160) { const int cnd = tid >> 5, col = tid & 31; float s = 0.f;
#pragma unroll 8
            for (int k2 = 0; k2 < 64; ++k2) s += red[(k2 * 5 + cnd) * 32 + col];
            modo[(size_t)(l * 5 + cnd) * NMODW + col0 + col] = s + p.b_ada[l * NMODW + col0 + col]; }
        __syncthreads();
    }
}

__device__ __forceinline__ void prep_phase(LAS unsigned char* lds) {
    const Params p = kparams();
    const int tid = opaque_tid(), lane = tid & 63, wave = __builtin_amdgcn_readfirstlane(tid >> 6), G = gridDim.x, gw = blockIdx.x * NWAVES + wave, NGW = G * NWAVES; (void)tid; (void)lane; (void)wave; (void)gw; (void)NGW; (void)G;
    unsigned char* ws = p.ws;
    convert_layer_weights(0, gw, NGW, lds);
    for (int it = gw; it < 2 * 4 * PAST; it += NGW) {
        const int alx = it >> 11, idx = it & 2047, b = idx >> 9, pp = idx & (PAST - 1);
        const size_t srco = ((size_t)(b * 2 + alx) * PAST + pp) * KVW + lane * 4, dst = ((size_t)b * KV_S + SEQ_S + pp) * KVW + lane * 4;
        const f32x4 kv = *(const f32x4*)(p.cache_k + srco), vv = *(const f32x4*)(p.cache_v + srco);
        u32x2 wk, wv; wk.x = cvt_pk_bf16(kv[0], kv[1]); wk.y = cvt_pk_bf16(kv[2], kv[3]); wv.x = cvt_pk_bf16(vv[0], vv[1]); wv.y = cvt_pk_bf16(vv[2], vv[3]);
        *(u32x2*)((bf16_t*)(ws + WS_KS + (size_t)alx * KVS_LAYER) + dst) = wk; *(u32x2*)((bf16_t*)(ws + WS_VS + (size_t)alx * KVS_LAYER) + dst) = wv;
    }
}

__device__ __forceinline__ void rowpass(const float* xsrc_p, const float* xsrc_s, float* xdst, const float* yraw,
                                        const float* modg, int gate_idx, const float* g_post, const float* modh, int shift_idx, const float* g_pre, bf16_t* H, bf16_t* X16) {
    const int tid = opaque_tid(), lane = tid & 63, wave = __builtin_amdgcn_readfirstlane(tid >> 6), G = gridDim.x, gw = blockIdx.x * NWAVES + wave, NGW = G * NWAVES; (void)tid; (void)lane; (void)wave; (void)gw; (void)NGW; (void)G;
    for (int r0 = gw * 8; r0 < NTOK; r0 += NGW * 8) {
        const int cond = r0 < NP ? 0 : 1 + ((r0 - NP) >> 11);
        f32x4 Gv[4], Av[4], Bv[4];
#pragma unroll
        for (int j = 0; j < 4; ++j) { const int col = 4 * lane + 256 * j;
            Gv[j] = (f32x4){0.f, 0.f, 0.f, 0.f}; Av[j] = Gv[j]; Bv[j] = Gv[j];
            if (yraw) Gv[j] = *(const f32x4*)(modg + (size_t)cond * NMODW + gate_idx * DM + col) * *(const f32x4*)(g_post + col);
            if (H) { const f32x4 sh = *(const f32x4*)(modh + (size_t)cond * NMODW + shift_idx * DM + col), scl = *(const f32x4*)(modh + (size_t)cond * NMODW + (shift_idx + 1) * DM + col);
                Av[j] = *(const f32x4*)(g_pre + col) * (scl + 1.0f); Bv[j] = sh; } }
#pragma unroll 4
        for (int i = 0; i < 8; ++i) { const int row = r0 + i;
            const float* xr = row < NP ? xsrc_p + (size_t)row * DM : xsrc_s + (size_t)(row - NP) * DM;
            f32x4 v[4];
#pragma unroll
            for (int j = 0; j < 4; ++j) v[j] = *(const f32x4*)(xr + 4 * lane + 256 * j);
            if (yraw) { f32x4 y[4]; float ss = 0.f;
#pragma unroll
                for (int j = 0; j < 4; ++j) { y[j] = *(const f32x4*)(yraw + (size_t)row * DM + 4 * lane + 256 * j); ss += (y[j][0] * y[j][0] + y[j][1] * y[j][1]) + (y[j][2] * y[j][2] + y[j][3] * y[j][3]); }
                const float rs = 1.0f / sqrtf(wave_sum(ss) * (1.0f / DM) + EPS);
#pragma unroll
                for (int j = 0; j < 4; ++j) v[j] += Gv[j] * (y[j] * rs); }
            if (xdst) {
#pragma unroll
                for (int j = 0; j < 4; ++j) *(f32x4*)(xdst + (size_t)row * DM + 4 * lane + 256 * j) = v[j]; }
            if (X16) {
#pragma unroll
                for (int j = 0; j < 4; ++j) { u32x2 w; w.x = cvt_pk_bf16(v[j][0], v[j][1]); w.y = cvt_pk_bf16(v[j][2], v[j][3]); *(u32x2*)(X16 + (size_t)row * DM + 4 * lane + 256 * j) = w; } }
            if (H) { float ss = 0.f;
#pragma unroll
                for (int j = 0; j < 4; ++j) ss += (v[j][0] * v[j][0] + v[j][1] * v[j][1]) + (v[j][2] * v[j][2] + v[j][3] * v[j][3]);
                const float rs = 1.0f / sqrtf(wave_sum(ss) * (1.0f / DM) + EPS);
#pragma unroll
                for (int j = 0; j < 4; ++j) { const f32x4 h = (v[j] * rs) * Av[j] + Bv[j]; u32x2 w; w.x = cvt_pk_bf16(h[0], h[1]); w.y = cvt_pk_bf16(h[2], h[3]);
                    *(u32x2*)(H + (size_t)row * DM + 4 * lane + 256 * j) = w; } }
        }
    }
}

template <int GI> __device__ __forceinline__ void pool_item(const bf16_t* H, bf16_t* P, int chunk, int lane) {
    constexpr int half = 1 << GI, NR = 31 + 2 * half;
    const int t0 = chunk * 32;
    int ss, T; if (t0 < NP) { ss = t0 & ~(SEQ_P - 1); T = SEQ_P; } else { ss = NP + ((t0 - NP) & ~(SEQ_S - 1)); T = SEQ_S; }
    const int tl0 = t0 - ss;
    const bf16_t* base = H + (size_t)ss * DM + GI * 256 + lane * 4;
    u32x2 v[NR];
#pragma unroll
    for (int i = 0; i < NR; ++i) { const int rl = tl0 - half + i; const bool ok = (rl >= 0) && (rl < T); const u32x2 x = *(const u32x2*)(base + (size_t)(ok ? rl : tl0) * DM); v[i].x = ok ? x.x : 0u; v[i].y = ok ? x.y : 0u; }
    f32x4 S = (f32x4){0.f, 0.f, 0.f, 0.f};
#pragma unroll
    for (int i = 0; i < 2 * half; ++i) { S[0] += bf_lo(v[i].x); S[1] += bf_hi(v[i].x); S[2] += bf_lo(v[i].y); S[3] += bf_hi(v[i].y); }
    bf16_t* out = P + (size_t)t0 * DM + GI * 256 + lane * 4;
#pragma unroll
    for (int j = 0; j < 32; ++j) { const int tl = tl0 + j; const int lo = tl - half < 0 ? 0 : tl - half, hi = tl + half > T ? T : tl + half; const float inv = 1.0f / (float)(hi - lo);
        const u32x2 c = v[j + half]; u32x2 w; w.x = cvt_pk_bf16(S[0] * inv - bf_lo(c.x), S[1] * inv - bf_hi(c.x)); w.y = cvt_pk_bf16(S[2] * inv - bf_lo(c.y), S[3] * inv - bf_hi(c.y));
        *(u32x2*)(out + (size_t)j * DM) = w;
        if (j < 31) { const u32x2 a = v[j + 2 * half], d = v[j]; S[0] += bf_lo(a.x) - bf_lo(d.x); S[1] += bf_hi(a.x) - bf_hi(d.x); S[2] += bf_lo(a.y) - bf_lo(d.y); S[3] += bf_hi(a.y) - bf_hi(d.y); } }
}
template <int GI> __device__ __forceinline__ void pool_item_x(const bf16_t* X16, const float* RS, f32x4 Av, bf16_t* P, int chunk, int lane) {
    constexpr int half = 1 << GI, NR = 31 + 2 * half;
    const int t0 = chunk * 32;
    int ss, T; if (t0 < NP) { ss = t0 & ~(SEQ_P - 1); T = SEQ_P; } else { ss = NP + ((t0 - NP) & ~(SEQ_S - 1)); T = SEQ_S; }
    const int tl0 = t0 - ss;
    const bf16_t* base = X16 + (size_t)ss * DM + GI * 256 + lane * 4;
    u32x2 v[NR]; float rv[NR];
#pragma unroll
    for (int i = 0; i < NR; ++i) { const int rl = tl0 - half + i; const bool ok = (rl >= 0) && (rl < T); const int rc = ok ? rl : tl0;
        const u32x2 x = *(const u32x2*)(base + (size_t)rc * DM); v[i].x = ok ? x.x : 0u; v[i].y = ok ? x.y : 0u; rv[i] = RS[ss + rc]; }
#define XH(i) ((f32x4){bf_lo(v[i].x), bf_hi(v[i].x), bf_lo(v[i].y), bf_hi(v[i].y)} * rv[i])
    f32x4 S = (f32x4){0.f, 0.f, 0.f, 0.f};
#pragma unroll
    for (int i = 0; i < 2 * half; ++i) S += XH(i);
    bf16_t* out = P + (size_t)t0 * DM + GI * 256 + lane * 4;
#pragma unroll
    for (int j = 0; j < 32; ++j) { const int tl = tl0 + j; const int lo = tl - half < 0 ? 0 : tl - half, hi = tl + half > T ? T : tl + half; const float inv = 1.0f / (float)(hi - lo);
        const f32x4 o = Av * (S * inv - XH(j + half)); u32x2 w; w.x = cvt_pk_bf16(o[0], o[1]); w.y = cvt_pk_bf16(o[2], o[3]);
        *(u32x2*)(out + (size_t)j * DM) = w;
        if (j < 31) S += XH(j + 2 * half) - XH(j); }
#undef XH
}
__device__ __forceinline__ void pool_local(int l, bf16_t* P, int pm, int pn) {
    const Params p = kparams();
    const int tid = opaque_tid(), lane = tid & 63, wave = __builtin_amdgcn_readfirstlane(tid >> 6);
    const int chunk = pm * 8 + wave, rowt = pm * 256, cond = rowt < NP ? 0 : 1 + ((rowt - NP) >> 11), col = pn * 256 + lane * 4;
    const float* mod = (const float*)(p.ws + WS_MOD) + ((size_t)l * 5 + cond) * NMODW;
    const f32x4 Av = *(const f32x4*)(p.norm_gains + (size_t)(l * 4) * DM + col) * (*(const f32x4*)(mod + DM + col) + 1.0f);
    const bf16_t* X16 = (const bf16_t*)(p.ws + WS_X16 + (l == 3 ? X16_COPY : 0)); const float* RS = (const float*)(p.ws + WS_RS);
    if (pn == 0) pool_item_x<0>(X16, RS, Av, P, chunk, lane); else if (pn == 1) pool_item_x<1>(X16, RS, Av, P, chunk, lane); else if (pn == 2) pool_item_x<2>(X16, RS, Av, P, chunk, lane); else pool_item_x<3>(X16, RS, Av, P, chunk, lane);
    asm volatile("s_waitcnt vmcnt(0)" ::: "memory");
    __builtin_amdgcn_fence(__ATOMIC_ACQUIRE, "agent");
    asm volatile("s_waitcnt vmcnt(0)" ::: "memory");
    __syncthreads();
}
__device__ __forceinline__ void pool_pass(const bf16_t* H, bf16_t* P) {
    const int tid = opaque_tid(), lane = tid & 63, wave = __builtin_amdgcn_readfirstlane(tid >> 6), gw = blockIdx.x * NWAVES + wave, NGW = gridDim.x * NWAVES;
    for (int it = gw; it < (NTOK / 32) * 4; it += NGW) { const int chunk = it >> 2, g = it & 3;
        if (g == 0) pool_item<0>(H, P, chunk, lane); else if (g == 1) pool_item<1>(H, P, chunk, lane); else if (g == 2) pool_item<2>(H, P, chunk, lane); else pool_item<3>(H, P, chunk, lane); }
}

__device__ __forceinline__ void attn_phase(char* lds, int G, int al) {
    const Params p = kparams();
    unsigned char* ws = p.ws;
    const bf16_t* qkv = (const bf16_t*)(ws + WS_QKV); const bf16_t* Kp = (const bf16_t*)(ws + WS_KP); const bf16_t* Ks = (const bf16_t*)(ws + WS_KS + (size_t)al * KVS_LAYER);
    const bf16_t* Vp = (const bf16_t*)(ws + WS_VP); const bf16_t* Vs = (const bf16_t*)(ws + WS_VS + (size_t)al * KVS_LAYER); bf16_t* AO = (bf16_t*)(ws + WS_ATTO);
#pragma unroll 1
    for (int u = vcu(); u < 512; u += G) {
        const bf16_t *Qb, *Kh, *Vh; bf16_t* Ob; int seq;
        if (u < 256) { const int combo = u & 7, b = combo >> 1, kvh = combo & 1, w = u >> 3, hq = kvh * 4 + (w >> 3), qb = w & 7;
            const size_t row0 = (size_t)NP + b * SEQ_S + qb * 256;
            Qb = qkv + row0 * DM + hq * 128; Kh = Ks + (size_t)b * KV_S * KVW + kvh * 128; Vh = Vs + (size_t)b * KV_S * KVW + kvh * 128; Ob = AO + row0 * DM + hq * 128; seq = KV_S; }
        else { const int u2 = u - 256, b = u2 >> 3, hq = u2 & 7, kvh = hq >> 2; const size_t row0 = (size_t)b * SEQ_P;
            Qb = qkv + row0 * DM + hq * 128; Kh = Kp + row0 * KVW + kvh * 128; Vh = Vp + row0 * KVW + kvh * 128; Ob = AO + row0 * DM + hq * 128; seq = SEQ_P; }
        attn::attn_dense_body(Qb, Kh, Vh, Ob, seq, lds);
        __syncthreads();
    }
}


#define XB_TMO      128
#define XB_XCNT(j)  (256  + 64 * (j))
#define XB_XSUB(j)  (1280 + 64 * (j))
#define XB_XGEN(j)  (2304 + 64 * (j))
#define XB_TOP      3328
#define XB_TOPGEN   3392
#define XCD_BAR_WORDS 3456
#define XB_SPIN_CAP (1u << 18)
__device__ __forceinline__ unsigned xb_ld(unsigned* p)              { return __hip_atomic_load(p, __ATOMIC_RELAXED, __HIP_MEMORY_SCOPE_AGENT); }
__device__ __forceinline__ unsigned xb_add(unsigned* p, unsigned v) { return __hip_atomic_fetch_add(p, v, __ATOMIC_RELAXED, __HIP_MEMORY_SCOPE_AGENT); }
__device__ __forceinline__ unsigned xb_xcc_id() { return (unsigned)__builtin_amdgcn_s_getreg((3 << 11) | 20) & 0xFu; }
#define XB_SPIN(cond, bar) do { unsigned _sp = 0; while (cond) { __builtin_amdgcn_s_sleep(1); \
    if ((++_sp & 255u) == 0u) { if (xb_ld(&(bar)[XB_TMO])) break; if (_sp > XB_SPIN_CAP) { atomicAdd(&(bar)[XB_TMO], 1u); break; } } } } while (0)
__device__ __forceinline__ void xcd_barrier_post(unsigned* bar, volatile LAS unsigned* misc) {
    if (opaque_tid() == 0) { const unsigned x = xb_xcc_id(); misc[16] = xb_add(&bar[XB_XCNT(x)], 1u); misc[17] = x; }
}
__device__ __forceinline__ void xcd_barrier_complete(unsigned* bar, unsigned x, unsigned& nloc, unsigned& nx) {
    const unsigned G = gridDim.x * gridDim.y * gridDim.z;
    unsigned sum, cnt, mine, sp = 0u;
    for (;;) {
        sum = 0u; cnt = 0u; mine = 0u;
#pragma unroll
        for (unsigned j = 0; j < 16; ++j) { const unsigned c = xb_ld(&bar[XB_XCNT(j)]); sum += c; cnt += (c > 0u) ? 1u : 0u; mine = (j == x) ? c : mine; }
        if (sum == G) break;
        __builtin_amdgcn_s_sleep(1);
        if ((++sp & 255u) == 0u) { if (xb_ld(&bar[XB_TMO])) break; if (sp > XB_SPIN_CAP) { atomicAdd(&bar[XB_TMO], 1u); break; } }
    }
    nloc = mine > 0u ? mine : 1u; nx = cnt > 0u ? cnt : 1u;
}
__device__ __forceinline__ bool xcd_census_uniform(unsigned* bar) {
    bool ok = (gridDim.x == 256);
#pragma unroll
    for (unsigned j = 0; j < 16; ++j) { const unsigned c = xb_ld(&bar[XB_XCNT(j)]); ok = ok && (j < 8u ? c == 32u : c == 0u); }
    return ok;
}
extern __shared__ __attribute__((aligned(16))) unsigned char lds_raw[];
constexpr int MISC_OFF = 147456 - 128;
__device__ __forceinline__ void xcd_barrier_now() {
    asm volatile("s_waitcnt vmcnt(0)" ::: "memory");
    __syncthreads();
    if (opaque_tid() == 0) {
        const Params kp = kparams();
        unsigned* bar = (unsigned*)kp.ws + CW_BAR; const unsigned x = xb_xcc_id();
        volatile LAS unsigned* st = (volatile LAS unsigned*)((LAS unsigned char*)lds_raw + MISC_OFF + 32);
        __builtin_amdgcn_s_waitcnt(0);
        unsigned nloc = st[0], nx = st[1];
        if (nloc == 0u) { xcd_barrier_complete(bar, x, nloc, nx); st[0] = nloc; st[1] = nx; st[10] = xcd_census_uniform(bar) ? 1u : 0u; }
        const unsigned old = xb_add(&bar[XB_XSUB(x)], 1u);
        const unsigned gen = old / nloc;
        if (old + 1u == (gen + 1u) * nloc) {
            __builtin_amdgcn_fence(__ATOMIC_RELEASE, "agent");
            asm volatile("s_waitcnt vmcnt(0)" ::: "memory");
            const unsigned og = xb_add(&bar[XB_TOP], 1u);
            const unsigned tg = og / nx;
            if (og + 1u == (tg + 1u) * nx) xb_add(&bar[XB_TOPGEN], 1u);
            else XB_SPIN(xb_ld(&bar[XB_TOPGEN]) == tg, bar);
            __builtin_amdgcn_fence(__ATOMIC_ACQUIRE, "agent");
            xb_add(&bar[XB_XGEN(x)], 1u);
            asm volatile("s_waitcnt vmcnt(0)" ::: "memory");
        } else {
            XB_SPIN(xb_ld(&bar[XB_XGEN(x)]) == gen, bar);
            __builtin_amdgcn_fence(__ATOMIC_ACQUIRE, "agent");
            asm volatile("s_waitcnt vmcnt(0)" ::: "memory");
        }
    }
    __syncthreads();
}


__device__ __forceinline__ bool census_uniform() { return ((volatile LAS unsigned*)((LAS unsigned char*)lds_raw + MISC_OFF))[18] != 0u; }
__device__ __forceinline__ int vcu() {
    volatile LAS unsigned* misc = (volatile LAS unsigned*)((LAS unsigned char*)lds_raw + MISC_OFF);
    const unsigned v = misc[18] != 0u ? misc[16] * 8u + misc[17] : blockIdx.x;
    return __builtin_amdgcn_readfirstlane((int)v);
}
__device__ __forceinline__ void xcc_barrier_now() {
    if (!census_uniform()) { xcd_barrier_now(); return; }
    asm volatile("s_waitcnt vmcnt(0)" ::: "memory");
    __syncthreads();
    if (opaque_tid() == 0) {
        const Params kp = kparams();
        unsigned* ctl = (unsigned*)kp.ws; unsigned* bar = ctl + CW_BAR; const unsigned x = xb_xcc_id();
        __builtin_amdgcn_s_waitcnt(0);
        const unsigned old = xb_add(&ctl[1024 + 64 * x], 1u);
        const unsigned gen = old / 32u;
        if (old + 1u == (gen + 1u) * 32u) xb_add(&ctl[2048 + 64 * x], 1u);
        else XB_SPIN(xb_ld(&ctl[2048 + 64 * x]) == gen, bar);
        __builtin_amdgcn_fence(__ATOMIC_ACQUIRE, "agent");
        asm volatile("s_waitcnt vmcnt(0)" ::: "memory");
    }
    __syncthreads();
}

__global__ void __launch_bounds__(NWAVES * 64, 2) mega_fwd(Params p_unused) {
    cg::grid_group grid = cg::this_grid();
    LAS unsigned char* lds = (LAS unsigned char*)lds_raw;
    const int G = gridDim.x;
    volatile LAS unsigned* MISC = (volatile LAS unsigned*)(lds + MISC_OFF);
    if (threadIdx.x < 32) MISC[threadIdx.x] = 0u;
    __syncthreads();
    { const Params p = kparams(); xcd_barrier_post((unsigned*)p.ws + CW_BAR, MISC); }

    { const Params p = kparams(); u32x4* z = (u32x4*)(p.ws + WS_XB1);
      for (int i = (int)blockIdx.x * (NWAVES * 64) + (int)threadIdx.x; i < (int)(2 * 524288 / 16); i += G * NWAVES * 64) z[i] = (u32x4){0u, 0u, 0u, 0u}; }
    mod_items(0, 192, (int)blockIdx.x, G, lds);
    if (gridDim.y == 12345u) grid.sync();
    xcd_barrier_now();
    { const Params p = kparams(); const float* mod = (const float*)(p.ws + WS_MOD);
      rowpass(p.x_prompt, p.x_sample, nullptr, nullptr, mod, 5, p.norm_gains, mod, 0, p.norm_gains, (bf16_t*)(p.ws + WS_H), (bf16_t*)(p.ws + WS_X16)); }
    prep_phase(lds);
    xcd_barrier_now();

    unsigned seq = 0;
#pragma unroll 1
    for (int l = 0; l < 4; ++l) {
        if ((l & 1) == 0) {
            const int al = l >> 1;
            { const Params p = kparams();
              pg8::Gemm g{(const bf16_t*)(p.ws + WS_H), (const bf16_t*)(p.ws + WS_WQKV) + (size_t)al * QKVW * DM, NTOK, QKVW, DM, DM, 0};
              pg8::StaticOrder S; S.init(NTOK, QKVW, G, vcu());
              pg8::EpiQKV E{al};
              pg8::gemm_phase<pg8::EpiQKV, pg8::StaticOrder, true>(lds, g, S, E);
            }
            if (l == 0) { const int R = (64 * 6) % G, nidle = R ? G - R : G, bi = R ? vcu() - R : vcu();
                if (bi >= 0) mod_items(192, 768, bi, nidle, lds); }
            xcd_barrier_now();
            attn_phase((char*)lds_raw, G, al);
            xcd_barrier_now();
        } else {
            const Params p = kparams();
            if (G == 256) { pg8::StaticOrder S; S.init(NTOK, DM, G, vcu()); pg8::Unit u; S.next(0, u);
                pool_local(l, (bf16_t*)(p.ws + WS_QKV), u.pm, u.pn); }
            else { pool_pass((const bf16_t*)(p.ws + WS_H), (bf16_t*)(p.ws + WS_QKV)); xcd_barrier_now(); }
        }
        { const Params p = kparams();
          pg8::Gemm gm;
          if ((l & 1) == 0) gm = pg8::Gemm{(const bf16_t*)(p.ws + WS_ATTO), (const bf16_t*)(p.ws + WS_WO) + (size_t)(l >> 1) * DM * DM, NTOK, DM, DM, DM, 0};
          else gm = pg8::Gemm{(const bf16_t*)(p.ws + WS_QKV), (const bf16_t*)(p.ws + WS_WPOOL) + (size_t)(l >> 1) * DM * 256, NTOK, DM, 256, DM, 256};
          pg8::StaticOrder S; S.init(NTOK, DM, G, vcu());
          pg8::EpiFused E{l, 0, 32u * (seq + 1u)}; ++seq;
          pg8::gemm_phase<pg8::EpiFused, pg8::StaticOrder, false>(lds, gm, S, E); }
        xcc_barrier_now();
        { const Params p = kparams();
          pg8::Gemm g{(const bf16_t*)(p.ws + WS_H), (const bf16_t*)(p.ws + WS_WUP) + (size_t)l * 2 * DFF * DM, NTOK, 2 * DFF, DM, DM, 0};
          pg8::StaticOrder S; S.init(NTOK, 2 * DFF, G, vcu());
          pg8::EpiSwiGLU E{(bf16_t*)(p.ws + WS_ACT)};
          pg8::gemm_phase<pg8::EpiSwiGLU, pg8::StaticOrder, true>(lds, g, S, E);
        }
        if (l < 3) { const int R = (64 * 22) % G, nidle = R ? G - R : G; const int bi = R ? vcu() - R : vcu();
            if (bi >= 0) convert_layer_weights(l + 1, bi * NWAVES + __builtin_amdgcn_readfirstlane(opaque_tid() >> 6), nidle * NWAVES, lds); }
        if (l < 3) xcd_barrier_now();
        else xcc_barrier_now();
        { const Params p = kparams();
          pg8::Gemm g{(const bf16_t*)(p.ws + WS_ACT), (const bf16_t*)(p.ws + WS_WDN) + (size_t)l * DM * DFF, NTOK, DM, DFF, DFF, 0};
          pg8::StaticOrder S; S.init(NTOK, DM, G, vcu());
          pg8::EpiFused E{l, 1, 32u * (seq + 1u)}; ++seq;
          pg8::gemm_phase<pg8::EpiFused, pg8::StaticOrder, false>(lds, g, S, E); }
        if (l < 3) xcc_barrier_now();
    }
}

extern "C" void kernel_launch(void* const* d_in, const int* in_sizes, int n_in, void* d_out, int out_size, void* d_ws, size_t ws_size, hipStream_t stream) {
    static int grid = 0;
    if (grid == 0) {
        if (n_in != 16 || ws_size < WS_END) { fprintf(stderr, "kernel_launch: unexpected n_in %d / ws_size %zu (need %zu)\n", n_in, ws_size, (size_t)WS_END); grid = -1; return; }
        int dev = 0, cus = 0, per_cu = 0;
        if (hipGetDevice(&dev) != hipSuccess || hipDeviceGetAttribute(&cus, hipDeviceAttributeMultiprocessorCount, dev) != hipSuccess) { grid = -1; return; }
        if (hipFuncSetAttribute((const void*)mega_fwd, hipFuncAttributeMaxDynamicSharedMemorySize, LDS_BYTES) != hipSuccess) { fprintf(stderr, "kernel_launch: hipFuncSetAttribute failed\n"); grid = -1; return; }
        if (hipOccupancyMaxActiveBlocksPerMultiprocessor(&per_cu, (const void*)mega_fwd, NWAVES * 64, LDS_BYTES) != hipSuccess || per_cu < 1) { fprintf(stderr, "kernel_launch: occupancy query says %d\n", per_cu); per_cu = 1; }
        (void)hipGetLastError();
        grid = cus;
    }
    if (grid < 0) return;
    if (hipMemsetAsync(d_ws, 0, CTL_ZERO_BYTES, stream) != hipSuccess) { fprintf(stderr, "kernel_launch: memset failed\n"); return; }
    Params p{};
    p.x_prompt = (const float*)d_in[0]; p.x_sample = (const float*)d_in[1]; p.c = (const float*)d_in[2]; p.cache_k = (const float*)d_in[3]; p.cache_v = (const float*)d_in[4];
    p.c_ctx = (const float*)d_in[5]; p.w_ada = (const float*)d_in[6]; p.b_ada = (const float*)d_in[7]; p.norm_gains = (const float*)d_in[8]; p.w_qkv = (const float*)d_in[9];
    p.qk_gains = (const float*)d_in[10]; p.w_o = (const float*)d_in[11]; p.w_pool = (const float*)d_in[12]; p.pool_scale = (const float*)d_in[13]; p.w_up = (const float*)d_in[14]; p.w_down = (const float*)d_in[15];
    p.out = (float*)d_out; p.ws = (unsigned char*)d_ws;
    void* args[] = {&p};
    const hipError_t e = hipLaunchCooperativeKernel((const void*)mega_fwd, dim3(grid), dim3(NWAVES * 64), args, LDS_BYTES, stream);
    if (e != hipSuccess) fprintf(stderr, "kernel_launch: cooperative launch failed: %s (grid %d)\n", hipGetErrorString(e), grid);
}
```

```cpp
#include <hip/hip_runtime.h>
#include <hip/hip_cooperative_groups.h>
#include <hip/hip_bf16.h>
#include <cstdio>
#include <cstdint>
namespace cg = cooperative_groups;

#define LAS __attribute__((address_space(3)))
typedef unsigned short bf16_t;
typedef short bf16x8 __attribute__((ext_vector_type(8)));
typedef short s16x4 __attribute__((ext_vector_type(4)));
typedef float f32x4 __attribute__((ext_vector_type(4)));
typedef float f32x16 __attribute__((ext_vector_type(16)));
typedef unsigned u32x4 __attribute__((ext_vector_type(4)));
typedef unsigned u32x2 __attribute__((ext_vector_type(2)));

constexpr int DM = 1024, NP = 8192, NS = 8192, NTOK = NP + NS, DFF = 2816, QKVW = 1536, NMODW = 6144;
constexpr int SEQ_P = 256, SEQ_S = 2048, PAST = 512, KV_S = SEQ_S + PAST, KVW = 256;
constexpr float EPS = 1e-6f;
constexpr int NWAVES = 8;

constexpr size_t MiB = 1u << 20;
constexpr size_t WS_WQKV = 1 * MiB;
constexpr size_t WS_WO = 7 * MiB;
constexpr size_t WS_WPOOL = 11 * MiB;
constexpr size_t WS_WUP = 12 * MiB;
constexpr size_t WS_WDN = 56 * MiB;
constexpr size_t WS_MOD = 78 * MiB;
constexpr size_t WS_H = 80 * MiB;
constexpr size_t WS_X16 = 112 * MiB;
constexpr size_t X16_COPY = 32 * MiB;
constexpr size_t WS_MIX = 176 * MiB;
constexpr size_t WS_QKV = WS_MIX;
constexpr size_t WS_KP = WS_MIX + 32 * MiB;
constexpr size_t WS_VP = WS_MIX + 36 * MiB;
constexpr size_t WS_ATTO = WS_MIX + 40 * MiB;
constexpr size_t WS_KS = WS_MIX + 72 * MiB;
constexpr size_t WS_VS = WS_MIX + 82 * MiB;
constexpr size_t WS_ACT = WS_MIX + 92 * MiB;
constexpr size_t KVS_LAYER = 5 * MiB;
constexpr size_t WS_END = WS_MIX + 180 * MiB;

constexpr size_t CTL_ZERO_BYTES = 65536; constexpr int CW_BAR = 4096, CW_SEAM = 8192;
constexpr size_t WS_XB1 = 79 * MiB, WS_XB2 = 79 * MiB + 524288;
constexpr size_t WS_RS = 655360;
constexpr int LDS_BYTES = 147456;

struct Params {
    const float *x_prompt, *x_sample, *c, *cache_k, *cache_v, *c_ctx, *w_ada, *b_ada, *norm_gains, *w_qkv, *qk_gains, *w_o, *w_pool, *pool_scale, *w_up, *w_down;
    float* out; unsigned char* ws;
};

typedef const __attribute__((address_space(4))) Params* KParamsPtr;
__device__ __forceinline__ Params kparams() {
    KParamsPtr q = (KParamsPtr)__builtin_amdgcn_kernarg_segment_ptr(); asm volatile("" : "+s"(q));
    Params p;
    p.x_prompt = q->x_prompt; p.x_sample = q->x_sample; p.c = q->c; p.cache_k = q->cache_k; p.cache_v = q->cache_v; p.c_ctx = q->c_ctx; p.w_ada = q->w_ada; p.b_ada = q->b_ada;
    p.norm_gains = q->norm_gains; p.w_qkv = q->w_qkv; p.qk_gains = q->qk_gains; p.w_o = q->w_o; p.w_pool = q->w_pool; p.pool_scale = q->pool_scale; p.w_up = q->w_up; p.w_down = q->w_down;
    p.out = q->out; p.ws = q->ws;
    return p;
}

__device__ __forceinline__ unsigned cvt_pk_bf16(float lo, float hi) { unsigned r; asm volatile("v_cvt_pk_bf16_f32 %0, %1, %2" : "=v"(r) : "v"(lo), "v"(hi)); return r; }
__device__ __forceinline__ float bf_lo(unsigned u) { return __uint_as_float(u << 16); }
__device__ __forceinline__ float bf_hi(unsigned u) { return __uint_as_float(u & 0xffff0000u); }

__device__ __forceinline__ float sum_xor16(float v) { auto r = __builtin_amdgcn_permlane16_swap(__float_as_uint(v), __float_as_uint(v), false, false); return __uint_as_float(r[0]) + __uint_as_float(r[1]); }
__device__ __forceinline__ float sum_xor32(float v) { auto r = __builtin_amdgcn_permlane32_swap(__float_as_uint(v), __float_as_uint(v), false, false); return __uint_as_float(r[0]) + __uint_as_float(r[1]); }
template <int CTRL> __device__ __forceinline__ float dpp_f(float v) { return __uint_as_float((unsigned)__builtin_amdgcn_update_dpp(0, (int)__float_as_uint(v), CTRL, 0xf, 0xf, true)); }
__device__ __forceinline__ float row16_sum(float v) { v += dpp_f<0x128>(v); v += dpp_f<0x124>(v); v += dpp_f<0x122>(v); v += dpp_f<0x121>(v); return v; }
__device__ __forceinline__ float wave_sum(float v) { return sum_xor32(sum_xor16(row16_sum(v))); }
__device__ __forceinline__ int opaque_tid() { int t = threadIdx.x; asm volatile("" : "+v"(t)); return t; }
__device__ __forceinline__ int vcu();
__device__ __forceinline__ float silu_f(float x) { return x / (1.0f + __expf(-x)); }

namespace pg8 {
constexpr int BM = 256, BK = 64, HALF = 128, HTB = HALF * BK * 2, STAGE_BYTES = 8 * HTB, NXCD = 8, WGM = 8;
__host__ __device__ __forceinline__ int lds_byte(int r, int c) { const int st = (r >> 4) * 2 + (c >> 5), rr = r & 15, cc = c & 31, ob = rr * 64 + cc * 2; return st * 1024 + (ob ^ (((ob >> 9) & 1) << 5)); }
__host__ __device__ __forceinline__ void stage_rc(int b, int& R, int& C) { const int st = b / 1024, sb = b % 1024, swz = sb ^ (((sb >> 9) & 1) << 5); R = (st >> 1) * 16 + swz / 64; C = (st & 1) * 32 + (swz % 64) / 2; }
__host__ __device__ __forceinline__ int perm32(int rho) { const int n = rho >> 4, i = rho & 15; return 8 * (i >> 2) + 4 * n + (i & 3); }

struct Unit { int pm, pn; };
struct Gemm { const bf16_t* A; const bf16_t* Bt; int M, N, K; int lda; int acol; };

struct StaticOrder {
    int nM, nN, nwg, G, c;
    __device__ void init(int M, int N, int G_, int c_) { nM = M / BM; nN = N / BM; nwg = nM * nN; G = G_; c = c_; }
    __device__ bool next(int i, Unit& u) const {
        const long L = (long)i * G + c; if (L >= nwg) return false;
        int wgid = (int)L; { const int q = nwg / NXCD, r = nwg % NXCD, xcd = wgid % NXCD, off = wgid / NXCD; wgid = (xcd < r ? xcd * (q + 1) : r * (q + 1) + (xcd - r) * q) + off; }
        const int nig = WGM * nN, gid = wgid / nig, fm = gid * WGM, gsz = (nM - fm) < WGM ? (nM - fm) : WGM;
        u.pm = fm + ((wgid % nig) % gsz); u.pn = (wgid % nig) / gsz; return true;
    }
};

struct EpiBf16 {
    static constexpr bool PERM = true, AFTER_DRAIN = false;
    bf16_t* O; int ldc;
    __device__ __forceinline__ void operator()(const f32x4 (&acc)[2][2][4][2], const Unit& u, int wr, int wc, int fr, int fq, LAS unsigned char* lds) const {
        const int row0 = u.pm * BM + wr * 64 + fr; const int col0 = u.pn * BM + wc * 32 + 8 * fq;
#pragma unroll
        for (int ai = 0; ai < 2; ++ai)
#pragma unroll
            for (int m = 0; m < 4; ++m) { bf16_t* rowp = O + (size_t)(row0 + ai * HALF + m * 16) * ldc + col0;
#pragma unroll
                for (int bj = 0; bj < 2; ++bj) { const f32x4 v0 = acc[ai][bj][m][0], v1 = acc[ai][bj][m][1];
                    u32x4 w; w.x = cvt_pk_bf16(v0[0], v0[1]); w.y = cvt_pk_bf16(v0[2], v0[3]); w.z = cvt_pk_bf16(v1[0], v1[1]); w.w = cvt_pk_bf16(v1[2], v1[3]);
                    *(u32x4*)(rowp + bj * HALF) = w; } }
    }
};

template <int KIND, bool SMP>
__device__ __forceinline__ void qkv_body(const f32x4 (&acc)[2][2][4][2], const LAS float* XS, bf16_t* dst, int dstride, float* onew, int rl0, int ntok0, int a, f32x4 g1, f32x4 g2, f32x4 inv) {
#pragma unroll
    for (int ai = 0; ai < 2; ++ai)
#pragma unroll
        for (int m = 0; m < 4; ++m) { const int rl = ai * HALF + rl0 + m * 16;
            f32x4 cs, sn;
            if (SMP && KIND < 2) { const int ntok = ntok0 + rl; const float pos = (float)(a == 0 ? (ntok >> 6) : (ntok & 63));
#pragma unroll
                for (int j = 0; j < 4; ++j) { const float rev = __builtin_amdgcn_fractf(pos * inv[j]); sn[j] = __builtin_amdgcn_sinf(rev); cs[j] = __builtin_amdgcn_cosf(rev); } }
#pragma unroll
            for (int bj = 0; bj < 2; ++bj) { f32x4 o1 = acc[ai][bj][m][0], o2 = acc[ai][bj][m][1];
                if (KIND < 2) { const f32x4 ps = *(const LAS f32x4*)(XS + (rl * 2 + bj) * 4); const float rs = __builtin_amdgcn_rsqf(((ps[0] + ps[1]) + (ps[2] + ps[3])) * (1.0f / 128.0f) + 1e-6f);
                    const f32x4 y1 = o1 * rs * g1, y2 = o2 * rs * g2;
                    if (SMP) { o1 = y1 * cs - y2 * sn; o2 = y2 * cs + y1 * sn; } else { o1 = y1; o2 = y2; } }
                u32x2 w1, w2; w1.x = cvt_pk_bf16(o1[0], o1[1]); w1.y = cvt_pk_bf16(o1[2], o1[3]); w2.x = cvt_pk_bf16(o2[0], o2[1]); w2.y = cvt_pk_bf16(o2[2], o2[3]);
                bf16_t* d = dst + rl * dstride + bj * 128; *(u32x2*)d = w1; *(u32x2*)(d + 32) = w2;
                if (KIND > 0 && !SMP) { float* o = onew + rl * 256 + bj * 128; *(f32x4*)o = o1; *(f32x4*)(o + 32) = o2; }
            }
            asm volatile("" ::: "memory"); __builtin_amdgcn_sched_barrier(0);
        }
}
struct EpiQKV {
    static constexpr bool PERM = true, AFTER_DRAIN = false;
    int al;
    __device__ __forceinline__ void operator()(const f32x4 (&acc)[2][2][4][2], const Unit& u, int wr, int wc, int fr, int fq, LAS unsigned char* lds) const {
        const Params kp = kparams();
        LAS float* XS = (LAS float*)(lds + STAGE_BYTES);
        const int pn = u.pn, rowt = u.pm * BM, rl0 = wr * 64 + fr;
        if (pn < 5) {
#pragma unroll
            for (int ai = 0; ai < 2; ++ai)
#pragma unroll
                for (int m = 0; m < 4; ++m)
#pragma unroll
                    for (int bj = 0; bj < 2; ++bj) { const f32x4 a0 = acc[ai][bj][m][0], a1 = acc[ai][bj][m][1];
                        float s = ((a0[0] * a0[0] + a0[1] * a0[1]) + (a0[2] * a0[2] + a0[3] * a0[3])) + ((a1[0] * a1[0] + a1[1] * a1[1]) + (a1[2] * a1[2] + a1[3] * a1[3]));
                        s = sum_xor32(sum_xor16(s));
                        if (fq == 0) XS[((ai * HALF + rl0 + m * 16) * 2 + bj) * 4 + wc] = s; }
        }
        asm volatile("s_waitcnt lgkmcnt(0)" ::: "memory"); __builtin_amdgcn_s_barrier(); asm volatile("" ::: "memory");
        const bool smp = rowt >= 8192;
        const int a = wc >> 1, pp0 = 16 * (wc & 1) + 4 * fq, d0 = 64 * a + pp0;
        f32x4 g1 = (f32x4){1.f, 1.f, 1.f, 1.f}, g2 = g1, inv = g1;
        if (pn < 5) { const float* gq = kp.qk_gains + (size_t)(al * 2 + (pn < 4 ? 0 : 1)) * 128; g1 = *(const f32x4*)(gq + d0); g2 = *(const f32x4*)(gq + d0 + 32);
#pragma unroll
            for (int j = 0; j < 4; ++j) inv[j] = __builtin_amdgcn_exp2f(-(float)(pp0 + j) * (13.287712379549449f / 32.0f)) * 0.15915494309189535f; }
        const int ntok0 = (rowt - 8192) & 2047, bs = (rowt - 8192) >> 11;
        if (pn < 4) { bf16_t* dst = (bf16_t*)(kp.ws + WS_QKV) + (size_t)rowt * 1024 + 2 * pn * 128 + d0;
            if (smp) qkv_body<0, true>(acc, XS, dst, 1024, nullptr, rl0, ntok0, a, g1, g2, inv); else qkv_body<0, false>(acc, XS, dst, 1024, nullptr, rl0, ntok0, a, g1, g2, inv); }
        else { const bool isv = pn == 5;
            bf16_t* dst = smp ? (bf16_t*)(kp.ws + (isv ? WS_VS : WS_KS) + (size_t)al * KVS_LAYER) + ((size_t)bs * 2560 + ntok0) * 256 + d0 : (bf16_t*)(kp.ws + (isv ? WS_VP : WS_KP)) + (size_t)rowt * 256 + d0;
            float* onew = kp.out + (size_t)16384 * 1024 + (isv ? (size_t)32 * 2 * 256 * 256 : 0) + (size_t)((rowt >> 8) * 2 + al) * 65536 + d0;
            if (!isv) { if (smp) qkv_body<1, true>(acc, XS, dst, 256, onew, rl0, ntok0, a, g1, g2, inv); else qkv_body<1, false>(acc, XS, dst, 256, onew, rl0, ntok0, a, g1, g2, inv); }
            else { if (smp) qkv_body<2, true>(acc, XS, dst, 256, onew, rl0, ntok0, a, g1, g2, inv); else qkv_body<2, false>(acc, XS, dst, 256, onew, rl0, ntok0, a, g1, g2, inv); } }
    }
};
struct EpiSwiGLU {
    static constexpr bool PERM = true, AFTER_DRAIN = false;
    bf16_t* O;
    __device__ __forceinline__ void operator()(const f32x4 (&acc)[2][2][4][2], const Unit& u, int wr, int wc, int fr, int fq, LAS unsigned char* lds) const {
        const int row0 = u.pm * BM + wr * 64 + fr; const int col0 = u.pn * 128 + wc * 16 + 4 * fq;
#pragma unroll
        for (int ai = 0; ai < 2; ++ai)
#pragma unroll
            for (int m = 0; m < 4; ++m) { bf16_t* rowp = O + (size_t)(row0 + ai * HALF + m * 16) * DFF + col0;
#pragma unroll
                for (int bj = 0; bj < 2; ++bj) { const f32x4 g = acc[ai][bj][m][0], up = acc[ai][bj][m][1]; f32x4 v;
#pragma unroll
                    for (int j = 0; j < 4; ++j) v[j] = g[j] * __builtin_amdgcn_rcpf(1.0f + __builtin_amdgcn_exp2f(-1.4426950408889634f * g[j])) * up[j];
                    u32x2 w; w.x = cvt_pk_bf16(v[0], v[1]); w.y = cvt_pk_bf16(v[2], v[3]);
                    *(u32x2*)(rowp + bj * 64) = w; } }
    }
};
struct EpiF32 {
    static constexpr bool PERM = false, AFTER_DRAIN = false;
    float* O; int ldc; const float* colscale;
    __device__ __forceinline__ void operator()(const f32x4 (&acc)[2][2][4][2], const Unit& u, int wr, int wc, int fr, int fq, LAS unsigned char* lds) const {
        const int row0 = u.pm * BM + wr * 64 + fr; const int col0 = u.pn * BM + wc * 32 + 4 * fq;
#pragma unroll
        for (int bj = 0; bj < 2; ++bj)
#pragma unroll
            for (int n = 0; n < 2; ++n) { const int col = col0 + bj * HALF + n * 16;
                const f32x4 sc = colscale ? *(const f32x4*)(colscale + col) : (f32x4){1.f, 1.f, 1.f, 1.f};
#pragma unroll
                for (int ai = 0; ai < 2; ++ai)
#pragma unroll
                    for (int m = 0; m < 4; ++m) *(f32x4*)(O + (size_t)(row0 + ai * HALF + m * 16) * ldc + col) = acc[ai][bj][m][n] * sc; }
    }
};

struct PanelSS {
    unsigned long long* gran;
    unsigned tag;
    template <class F>
    __device__ __forceinline__ void run(const float (&part)[2][4], const Unit& u, int wr, int wc, int fr, int fq, LAS unsigned char* lds, int wid, int lane, F&& emit) const {
        LAS float* P = (LAS float*)lds;
        LAS float* S = (LAS float*)(lds + 4096);
#pragma unroll
        for (int ai = 0; ai < 2; ++ai)
#pragma unroll
            for (int m = 0; m < 4; ++m) { float s = part[ai][m]; s = sum_xor32(sum_xor16(s));
                if (fq == 0) P[(ai * HALF + wr * 64 + m * 16 + fr) * 4 + wc] = s; }
        asm volatile("s_waitcnt lgkmcnt(0)" ::: "memory"); __builtin_amdgcn_s_barrier(); asm volatile("" ::: "memory");
        const int row = wid * 32 + (lane & 31);
        unsigned long long* g = gran + (size_t)(u.pm * BM + row) * 4;
        if (lane < 32) { const float t = (P[row * 4 + 0] + P[row * 4 + 1]) + (P[row * 4 + 2] + P[row * 4 + 3]);
            __hip_atomic_store(g + u.pn, ((unsigned long long)tag << 32) | (unsigned long long)__float_as_uint(t), __ATOMIC_RELAXED, __HIP_MEMORY_SCOPE_AGENT); }
        emit();
        float tot = 0.f;
        for (unsigned spins = 0;;) {
            bool ok = true; tot = 0.f;
            if (lane < 32) {
#pragma unroll
                for (int q = 0; q < 4; ++q) { const unsigned long long x = __hip_atomic_load(g + q, __ATOMIC_RELAXED, __HIP_MEMORY_SCOPE_AGENT); ok = ok && ((unsigned)(x >> 32) == tag); tot += __uint_as_float((unsigned)x); } }
            if (__all(ok)) break;
            if (++spins > (1u << 20)) break;
            __builtin_amdgcn_s_sleep(1);
        }
        if (lane < 32) S[row] = __builtin_amdgcn_rsqf(tot * (1.0f / 1024.0f) + 1e-6f);
        asm volatile("s_waitcnt lgkmcnt(0)" ::: "memory"); __builtin_amdgcn_s_barrier(); asm volatile("" ::: "memory");
    }
};
struct EpiFused {
    static constexpr bool PERM = true, AFTER_DRAIN = true;
    int l, stage; unsigned want;
    __device__ __forceinline__ void fused(f32x4 (&acc)[2][2][4][2], const Unit& u, int wr, int wc, int fr, int fq, LAS unsigned char* lds, int wid, int lane) const {
        const Params kp = kparams();
        const unsigned kf = want / 32u - 1u, rb = (kf >= 3u && kf <= 6u) ? 1u : 0u, wb = (kf >= 2u && kf <= 5u) ? 1u : 0u;
        const bf16_t* X16 = (const bf16_t*)(kp.ws + WS_X16 + rb * X16_COPY); bf16_t* X16w = (bf16_t*)(kp.ws + WS_X16 + wb * X16_COPY); const float* mod = (const float*)(kp.ws + WS_MOD);
        const float* colscale = (stage == 0 && (l & 1)) ? kp.pool_scale + (size_t)(l >> 1) * 1024 : nullptr;
        const int ln = stage == 0 ? l : (l < 3 ? l + 1 : 3);
        const float* modg = mod + (size_t)l * 5 * 6144; const int gate_idx = stage == 0 ? 2 : 5; const float* g_post = kp.norm_gains + (size_t)(l * 4 + (stage == 0 ? 1 : 3)) * 1024;
        const float* modh = mod + (size_t)ln * 5 * 6144; const int shift_idx = stage == 0 ? 3 : 0; const float* g_pre = kp.norm_gains + (size_t)(ln * 4 + (stage == 0 ? 2 : 0)) * 1024;
        const bool last = (stage == 1 && l == 3);
        const PanelSS st1{(unsigned long long*)(kp.ws + WS_XB1), 2u * kf + 1u}, st2{(unsigned long long*)(kp.ws + WS_XB2), 2u * kf + 2u};
        const LAS float* S = (const LAS float*)(lds + 4096);
        const int col0 = u.pn * BM + wc * 32 + 8 * fq, rowt = u.pm * BM;
        const int cond = rowt < 8192 ? 0 : 1 + ((rowt - 8192) >> 11);
        u32x4 pre[2][4][2];
#pragma unroll
        for (int m = 0; m < 4; ++m) { const bf16_t* xr = X16 + (size_t)(rowt + wr * 64 + m * 16 + fr) * 1024 + col0;
#pragma unroll
            for (int bj = 0; bj < 2; ++bj) pre[0][m][bj] = *(const u32x4*)(xr + bj * HALF); }
        if (colscale) {
#pragma unroll
            for (int bj = 0; bj < 2; ++bj)
#pragma unroll
                for (int n = 0; n < 2; ++n) { const f32x4 sc = *(const f32x4*)(colscale + col0 + bj * HALF + n * 4);
#pragma unroll
                    for (int ai = 0; ai < 2; ++ai)
#pragma unroll
                        for (int m = 0; m < 4; ++m) acc[ai][bj][m][n] *= sc; }
        }
        float part[2][4];
#pragma unroll
        for (int ai = 0; ai < 2; ++ai)
#pragma unroll
            for (int m = 0; m < 4; ++m) { float s = 0.f;
#pragma unroll
                for (int bj = 0; bj < 2; ++bj)
#pragma unroll
                    for (int n = 0; n < 2; ++n) { const f32x4 v = acc[ai][bj][m][n]; s += (v[0] * v[0] + v[1] * v[1]) + (v[2] * v[2] + v[3] * v[3]); }
                part[ai][m] = s; }
        st1.run(part, u, wr, wc, fr, fq, lds, wid, lane, [] {});
#pragma unroll
        for (int m = 0; m < 4; ++m) { const bf16_t* xr = X16 + (size_t)(rowt + HALF + wr * 64 + m * 16 + fr) * 1024 + col0;
#pragma unroll
            for (int bj = 0; bj < 2; ++bj) pre[1][m][bj] = *(const u32x4*)(xr + bj * HALF); }
        {
            f32x4 Gv[2][2];
#pragma unroll
            for (int bj = 0; bj < 2; ++bj)
#pragma unroll
                for (int n = 0; n < 2; ++n) { const int col = col0 + bj * HALF + n * 4;
                    Gv[bj][n] = *(const f32x4*)(modg + (size_t)cond * 6144 + gate_idx * 1024 + col) * *(const f32x4*)(g_post + col); }
#pragma unroll
            for (int ai = 0; ai < 2; ++ai)
#pragma unroll
                for (int m = 0; m < 4; ++m) { const float rs = S[ai * HALF + wr * 64 + m * 16 + fr];
#pragma unroll
                    for (int bj = 0; bj < 2; ++bj) { const u32x4 xp = pre[ai][m][bj];
                        const f32x4 xv0 = (f32x4){bf_lo(xp.x), bf_hi(xp.x), bf_lo(xp.y), bf_hi(xp.y)}, xv1 = (f32x4){bf_lo(xp.z), bf_hi(xp.z), bf_lo(xp.w), bf_hi(xp.w)};
                        acc[ai][bj][m][0] = xv0 + Gv[bj][0] * (acc[ai][bj][m][0] * rs); acc[ai][bj][m][1] = xv1 + Gv[bj][1] * (acc[ai][bj][m][1] * rs); } }
        }
        if (!last) {
#pragma unroll
            for (int ai = 0; ai < 2; ++ai)
#pragma unroll
                for (int m = 0; m < 4; ++m) { float s = 0.f;
#pragma unroll
                    for (int bj = 0; bj < 2; ++bj)
#pragma unroll
                        for (int n = 0; n < 2; ++n) { const f32x4 v = acc[ai][bj][m][n]; s += (v[0] * v[0] + v[1] * v[1]) + (v[2] * v[2] + v[3] * v[3]); }
                    part[ai][m] = s; }
            st2.run(part, u, wr, wc, fr, fq, lds, wid, lane, [&] {
#pragma unroll
                for (int ai = 0; ai < 2; ++ai)
#pragma unroll
                    for (int m = 0; m < 4; ++m) { const size_t off = (size_t)(rowt + ai * HALF + wr * 64 + m * 16 + fr) * 1024 + col0;
#pragma unroll
                        for (int bj = 0; bj < 2; ++bj) { const f32x4 x0 = acc[ai][bj][m][0], x1 = acc[ai][bj][m][1];
                            u32x4 xw; xw.x = cvt_pk_bf16(x0[0], x0[1]); xw.y = cvt_pk_bf16(x0[2], x0[3]); xw.z = cvt_pk_bf16(x1[0], x1[1]); xw.w = cvt_pk_bf16(x1[2], x1[3]);
                            *(u32x4*)(X16w + off + bj * HALF) = xw; } }
            });
            asm volatile("" : "+v"(fr), "+v"(fq));
            const int col0 = u.pn * BM + wc * 32 + 8 * fq;
            if (stage == 1 && (l & 1) == 0 && gridDim.x == 256) {
                if (u.pn == 0 && lane < 32) ((float*)(kp.ws + WS_RS))[rowt + wid * 32 + lane] = S[wid * 32 + lane];
                return;
            }
            bf16_t* H = (bf16_t*)(kp.ws + WS_H);
            f32x4 Av[2][2], Bv[2][2];
#pragma unroll
            for (int bj = 0; bj < 2; ++bj)
#pragma unroll
                for (int n = 0; n < 2; ++n) { const int col = col0 + bj * HALF + n * 4;
                    Av[bj][n] = *(const f32x4*)(g_pre + col) * (*(const f32x4*)(modh + (size_t)cond * 6144 + (shift_idx + 1) * 1024 + col) + 1.0f);
                    Bv[bj][n] = *(const f32x4*)(modh + (size_t)cond * 6144 + shift_idx * 1024 + col); }
#pragma unroll
            for (int ai = 0; ai < 2; ++ai)
#pragma unroll
                for (int m = 0; m < 4; ++m) { const int r = ai * HALF + wr * 64 + m * 16 + fr; const float rs = S[r]; const size_t off = (size_t)(rowt + r) * 1024 + col0;
#pragma unroll
                    for (int bj = 0; bj < 2; ++bj) { const f32x4 x0 = acc[ai][bj][m][0], x1 = acc[ai][bj][m][1];
                        const f32x4 h0 = (x0 * rs) * Av[bj][0] + Bv[bj][0], h1 = (x1 * rs) * Av[bj][1] + Bv[bj][1];
                        u32x4 w; w.x = cvt_pk_bf16(h0[0], h0[1]); w.y = cvt_pk_bf16(h0[2], h0[3]); w.z = cvt_pk_bf16(h1[0], h1[1]); w.w = cvt_pk_bf16(h1[2], h1[3]);
                        *(u32x4*)(H + off + bj * HALF) = w; }
                    asm volatile("" ::: "memory"); }
        } else {
            float* X = kp.out;
#pragma unroll
            for (int ai = 0; ai < 2; ++ai)
#pragma unroll
                for (int m = 0; m < 4; ++m) { const size_t off = (size_t)(rowt + ai * HALF + wr * 64 + m * 16 + fr) * 1024 + col0;
#pragma unroll
                    for (int bj = 0; bj < 2; ++bj)
#pragma unroll
                        for (int n = 0; n < 2; ++n) *(f32x4*)(X + off + bj * HALF + n * 4) = acc[ai][bj][m][n]; }
        }
    }
};

template <class Epi, class Sched, bool ALIGN_EPI>
__device__ __forceinline__ void gemm_phase(LAS unsigned char* lds, const Gemm g, const Sched& S, const Epi& E) {
    const int tid = opaque_tid(), wid = __builtin_amdgcn_readfirstlane(tid >> 6), lane = tid & 63, wr = wid >> 2, wc = wid & 3, fr = lane & 15, fq = lane >> 4;
    const int K = g.K, nt = K / BK, lda = g.lda;
    unsigned voffA[2], voffB[2];
#pragma unroll
    for (int i = 0; i < 2; ++i) { int R, C; stage_rc(tid * 16 + i * 8192, R, C); const int Rb = Epi::PERM ? ((R & ~31) + perm32(R & 31)) : R;
        voffA[i] = (unsigned)(R * lda + C) * 2u; voffB[i] = (unsigned)(Rb * K + C) * 2u; }
    const size_t kstep = (size_t)(BK * 2);
    const size_t hA = (size_t)HALF * lda * 2, hB = (size_t)HALF * K * 2;
    const size_t tA = 2 * hA, tB = 2 * hB;
    const size_t acolB = (size_t)g.acol * 2;
    const unsigned ldsw = (unsigned)wid * 1024u;
    const int aoff = lds_byte(wr * 64 + fr, fq * 8), boff = lds_byte(wc * 32 + fr, fq * 8);
#define PG8_SA(b, h) (((b) * 2 + (h)) * HTB)
#define PG8_SB(b, h) ((4 + (b) * 2 + (h)) * HTB)
#define PG8_STAGE(bufoff, gbase, voff) do { _Pragma("unroll") for (int _i = 0; _i < 2; ++_i) \
        __builtin_amdgcn_global_load_lds((const unsigned*)((const char*)(gbase) + (voff)[_i]), (LAS unsigned*)(lds + (bufoff) + ldsw + _i * 8192), 16, 0, 0); } while (0)
#define PG8_LDA(dst, b, h) do { _Pragma("unroll") for (int m = 0; m < 4; ++m) _Pragma("unroll") for (int k = 0; k < 2; ++k) dst[m][k] = *(const LAS bf16x8*)(lds + PG8_SA(b, h) + aoff + m * 2048 + k * 1024); } while (0)
#define PG8_LDB(dst, b, h) do { _Pragma("unroll") for (int n = 0; n < 2; ++n) _Pragma("unroll") for (int k = 0; k < 2; ++k) dst[n][k] = *(const LAS bf16x8*)(lds + PG8_SB(b, h) + boff + n * 2048 + k * 1024); } while (0)
#define PG8_MMA(ai, bj, At, Bt) do { __builtin_amdgcn_s_setprio(1); _Pragma("unroll") for (int m = 0; m < 4; ++m) _Pragma("unroll") for (int n = 0; n < 2; ++n) _Pragma("unroll") for (int k = 0; k < 2; ++k) \
        acc[ai][bj][m][n] = __builtin_amdgcn_mfma_f32_16x16x32_bf16(Bt[n][k], At[m][k], acc[ai][bj][m][n], 0, 0, 0); __builtin_amdgcn_s_setprio(0); } while (0)
#define PG8_WAIT_V(n) asm volatile("s_waitcnt vmcnt(" #n ")" ::: "memory")
#define PG8_WAIT_L(n) asm volatile("s_waitcnt lgkmcnt(" #n ")" ::: "memory")
#define PG8_BAR __builtin_amdgcn_s_barrier()
#define PG8_SCHED __builtin_amdgcn_sched_barrier(0)
    Unit cur, nxt; int ui = 0;
    if (!S.next(0, cur)) return;
    f32x4 acc[2][2][4][2];
#pragma unroll
    for (int a = 0; a < 2; ++a)
#pragma unroll
        for (int b = 0; b < 2; ++b)
#pragma unroll
            for (int m = 0; m < 4; ++m)
#pragma unroll
                for (int n = 0; n < 2; ++n) acc[a][b][m][n] = (f32x4){0.f, 0.f, 0.f, 0.f};
    bf16x8 At[4][2], B0[2][2], B1[2][2];
    const char* cA = (const char*)g.A + (size_t)cur.pm * tA + (size_t)cur.pn * acolB; const char* cB = (const char*)g.Bt + (size_t)cur.pn * tB;
    PG8_STAGE(PG8_SB(0, 0), cB, voffB); PG8_STAGE(PG8_SB(0, 1), cB + hB, voffB); PG8_STAGE(PG8_SA(0, 0), cA, voffA); PG8_STAGE(PG8_SA(0, 1), cA + hA, voffA);
    if (wr == 1) PG8_BAR;
    PG8_WAIT_V(2); PG8_BAR;
    PG8_STAGE(PG8_SB(1, 0), cB + kstep, voffB); PG8_STAGE(PG8_SA(1, 0), cA + kstep, voffA); PG8_STAGE(PG8_SB(1, 1), cB + hB + kstep, voffB);
    PG8_WAIT_V(6); PG8_BAR;
    for (;;) {
        const bool has_next = S.next(ui + 1, nxt);
        const char* nA = has_next ? (const char*)g.A + (size_t)nxt.pm * tA + (size_t)nxt.pn * acolB : cA; const char* nB = has_next ? (const char*)g.Bt + (size_t)nxt.pn * tB : cB;
        for (int t = 0; t < nt; t += 2) {
            const bool last = (t == nt - 2);
            const char* a1 = cA + (size_t)(t + 1) * kstep;
            const char* a2 = last ? nA : cA + (size_t)(t + 2) * kstep; const char* b2 = last ? nB : cB + (size_t)(t + 2) * kstep;
            const char* a3 = a2 + kstep; const char* b3 = b2 + kstep;
            PG8_LDB(B0, 0, 0); PG8_LDB(B1, 0, 1); PG8_SCHED; PG8_LDA(At, 0, 0); PG8_STAGE(PG8_SA(1, 1), a1 + hA, voffA);
            PG8_WAIT_V(8); PG8_WAIT_L(0); PG8_BAR; PG8_MMA(0, 0, At, B0); PG8_MMA(0, 1, At, B1); PG8_BAR; PG8_SCHED;
            PG8_LDA(At, 0, 1); PG8_STAGE(PG8_SB(0, 0), b2, voffB); PG8_STAGE(PG8_SB(0, 1), b2 + hB, voffB); PG8_STAGE(PG8_SA(0, 0), a2, voffA);
            PG8_WAIT_V(8); PG8_WAIT_L(0); PG8_BAR; PG8_MMA(1, 0, At, B0); PG8_MMA(1, 1, At, B1); PG8_BAR; PG8_SCHED;
            PG8_LDB(B0, 1, 0); PG8_LDB(B1, 1, 1); PG8_SCHED; PG8_LDA(At, 1, 0); PG8_STAGE(PG8_SA(0, 1), a2 + hA, voffA);
            PG8_WAIT_V(8); PG8_WAIT_L(0); PG8_BAR; PG8_MMA(0, 0, At, B0); PG8_MMA(0, 1, At, B1); PG8_BAR; PG8_SCHED;
            PG8_LDA(At, 1, 1); PG8_STAGE(PG8_SB(1, 0), b3, voffB); PG8_STAGE(PG8_SB(1, 1), b3 + hB, voffB); PG8_STAGE(PG8_SA(1, 0), a3, voffA);
            PG8_WAIT_V(8); PG8_WAIT_L(0); PG8_BAR; PG8_MMA(1, 0, At, B0); PG8_MMA(1, 1, At, B1); PG8_BAR; PG8_SCHED;
        }
        if constexpr (ALIGN_EPI) { if (wr == 0) PG8_BAR; }
        if constexpr (!Epi::AFTER_DRAIN) { int fr_ = fr, fq_ = fq, wr_ = wr, wc_ = wc; asm volatile("" : "+v"(fr_), "+v"(fq_), "+s"(wr_), "+s"(wc_)); E(acc, cur, wr_, wc_, fr_, fq_, lds); }
        if (!has_next) break;
#pragma unroll
        for (int a = 0; a < 2; ++a)
#pragma unroll
            for (int b = 0; b < 2; ++b)
#pragma unroll
                for (int m = 0; m < 4; ++m)
#pragma unroll
                    for (int n = 0; n < 2; ++n) acc[a][b][m][n] = (f32x4){0.f, 0.f, 0.f, 0.f};
        cur = nxt; cA = nA; cB = nB; ++ui;
        if constexpr (ALIGN_EPI) { if (wr == 1) PG8_BAR; }
    }
    PG8_WAIT_V(0);
    if constexpr (!ALIGN_EPI) { if (wr == 0) PG8_BAR; }
    PG8_BAR;
    if constexpr (Epi::AFTER_DRAIN) { int fr_ = fr, fq_ = fq, wr_ = wr, wc_ = wc; asm volatile("" : "+v"(fr_), "+v"(fq_), "+s"(wr_), "+s"(wc_)); E.fused(acc, cur, wr_, wc_, fr_, fq_, lds, wid, lane); }
#undef PG8_SA
#undef PG8_SB
#undef PG8_STAGE
#undef PG8_LDA
#undef PG8_LDB
#undef PG8_MMA
#undef PG8_WAIT_V
#undef PG8_WAIT_L
#undef PG8_BAR
#undef PG8_SCHED
}
}

namespace attn {
constexpr int D = 128, NW = 8, QBLK = 32, KVBLK = 64;
constexpr float SCALE = 0.088388347648318440f;
constexpr float THR = 8.f;
constexpr int LDQ = DM, LDK = KVW, LDO = DM;
constexpr size_t SHM_V = KVBLK * D * 2, SHM_K = KVBLK * D * 2, SHM_ATTN = 2 * SHM_V + 2 * SHM_K + NW * 64 * 4;
#define KSWZ(row, colB) ((row) * 256 + ((colB) ^ (((row) & 7) << 4)))
#define SBAR() __builtin_amdgcn_sched_barrier(0)
__device__ __forceinline__ int crow(int r, int hi) { return (r & 3) + 8 * (r >> 2) + 4 * hi; }
__device__ __forceinline__ unsigned cvtpk(float lo, float hi) { unsigned r; asm volatile("v_cvt_pk_bf16_f32 %0, %1, %2" : "=v"(r) : "v"(lo), "v"(hi)); return r; }
__device__ __forceinline__ void partialSM(f32x16& p0, f32x16& p1, float& m_reg, float& mn, float& alpha) {
  constexpr float C = SCALE * 1.4426950408889634f;
  float pmax = p0[0]; for (int r = 1; r < 16; ++r) pmax = fmaxf(pmax, p0[r]); for (int r = 0; r < 16; ++r) pmax = fmaxf(pmax, p1[r]);
  { auto rr = __builtin_amdgcn_permlane32_swap(__float_as_uint(pmax), __float_as_uint(pmax), false, false);
    pmax = fmaxf(__uint_as_float(rr[0]), __uint_as_float(rr[1])); }
  if (__builtin_expect(__all(pmax - m_reg <= THR / SCALE), 1)) { mn = m_reg; alpha = 1.f; }
  else { mn = fmaxf(m_reg, pmax); alpha = __builtin_amdgcn_exp2f((m_reg - mn) * C); m_reg = mn; }
  float mnC = -mn * C;
  for (int r = 0; r < 16; ++r) p0[r] = fmaf(p0[r], C, mnC); for (int r = 0; r < 16; ++r) p1[r] = fmaf(p1[r], C, mnC);
  for (int r = 0; r < 16; ++r) p0[r] = __builtin_amdgcn_exp2f(p0[r]);
}
__device__ __forceinline__ void finishSM(f32x16& p0, f32x16& p1, float alpha, float& l_reg, bf16x8& pa0, bf16x8& pa1, bf16x8& pa2, bf16x8& pa3) {
  for (int r = 0; r < 16; ++r) p1[r] = __builtin_amdgcn_exp2f(p1[r]);
  float ps = 0; for (int r = 0; r < 16; ++r) ps += p0[r]; for (int r = 0; r < 16; ++r) ps += p1[r];
  { auto rr = __builtin_amdgcn_permlane32_swap(__float_as_uint(ps), __float_as_uint(ps), false, false);
    ps = __uint_as_float(rr[0]) + __uint_as_float(rr[1]); }
  l_reg = l_reg * alpha + ps;
#define PK4(P, BASE, OUT) do { unsigned a0 = cvtpk(P[BASE + 0], P[BASE + 1]), a1 = cvtpk(P[BASE + 2], P[BASE + 3]);   \
    unsigned b0 = cvtpk(P[BASE + 4], P[BASE + 5]), b1 = cvtpk(P[BASE + 6], P[BASE + 7]);                              \
    auto r0 = __builtin_amdgcn_permlane32_swap(a0, b0, false, false); auto r1 = __builtin_amdgcn_permlane32_swap(a1, b1, false, false); \
    u32x4 w = {r0[0], r1[0], r0[1], r1[1]}; OUT = *reinterpret_cast<bf16x8*>(&w); } while (0)
  PK4(p0, 0, pa0); PK4(p0, 8, pa1); PK4(p1, 0, pa2); PK4(p1, 8, pa3);
#undef PK4
}
__device__ __forceinline__ void qkt(f32x16& p0, f32x16& p1, const bf16_t* Ks, const bf16x8* qr, int r32, int hi) {
  p0 = f32x16{}; p1 = f32x16{};
#pragma unroll
  for (int d0 = 0; d0 < 8; ++d0) { int cb = (d0 * 16 + hi * 8) * 2;
    bf16x8 b0 = *reinterpret_cast<const bf16x8*>((const char*)Ks + KSWZ(r32, cb));
    bf16x8 b1 = *reinterpret_cast<const bf16x8*>((const char*)Ks + KSWZ(32 + r32, cb));
    p0 = __builtin_amdgcn_mfma_f32_32x32x16_bf16(b0, qr[d0], p0, 0, 0, 0);
    p1 = __builtin_amdgcn_mfma_f32_32x32x16_bf16(b1, qr[d0], p1, 0, 0, 0); }
}
__device__ __forceinline__ int v_st(int k, int c) { const int kk = (k & ~0xC) | ((k & 4) << 1) | ((k & 8) >> 1); return ((kk >> 3) * 4 + (c >> 5)) * 512 + ((kk & 7) * 32 + (c & 31)) * 2; }
__device__ __forceinline__ int v_rd_base(int lane) { return ((lane & 3) << 3) | (((lane >> 2) & 3) << 6) | (((lane >> 4) & 1) << 5) | (((lane >> 5) & 1) << 8); }
constexpr int v_rd_off(int d0, int ks, int half) { return d0 * 512 + ks * 4096 + half * 2048; }
template <int OFF> __device__ __forceinline__ s16x4 tr_read(int vb) {
  s16x4 r; asm volatile("ds_read_b64_tr_b16 %0, %1 offset:%2" : "=&v"(r) : "v"(vb), "i"(OFF) : "memory"); return r;
}
template <int D0> __device__ __forceinline__ void pv_one(f32x16& od, int vb, bf16x8 pa0, bf16x8 pa1, bf16x8 pa2, bf16x8 pa3) {
  const s16x4 l0 = tr_read<v_rd_off(D0, 0, 0)>(vb), h0 = tr_read<v_rd_off(D0, 0, 1)>(vb), l1 = tr_read<v_rd_off(D0, 1, 0)>(vb), h1 = tr_read<v_rd_off(D0, 1, 1)>(vb);
  const s16x4 l2 = tr_read<v_rd_off(D0, 2, 0)>(vb), h2 = tr_read<v_rd_off(D0, 2, 1)>(vb), l3 = tr_read<v_rd_off(D0, 3, 0)>(vb), h3 = tr_read<v_rd_off(D0, 3, 1)>(vb);
  asm volatile("s_waitcnt lgkmcnt(0)" ::: "memory"); SBAR();
#define PK(L, H) (bf16x8){L[0], L[1], L[2], L[3], H[0], H[1], H[2], H[3]}
  od = __builtin_amdgcn_mfma_f32_32x32x16_bf16(pa0, PK(l0, h0), od, 0, 0, 0);
  od = __builtin_amdgcn_mfma_f32_32x32x16_bf16(pa1, PK(l1, h1), od, 0, 0, 0);
  od = __builtin_amdgcn_mfma_f32_32x32x16_bf16(pa2, PK(l2, h2), od, 0, 0, 0);
  od = __builtin_amdgcn_mfma_f32_32x32x16_bf16(pa3, PK(l3, h3), od, 0, 0, 0);
#undef PK
}
__device__ __forceinline__ void pv_d0(f32x16* o, int vb, bf16x8 pa0, bf16x8 pa1, bf16x8 pa2, bf16x8 pa3) {
  pv_one<0>(o[0], vb, pa0, pa1, pa2, pa3); pv_one<1>(o[1], vb, pa0, pa1, pa2, pa3); pv_one<2>(o[2], vb, pa0, pa1, pa2, pa3); pv_one<3>(o[3], vb, pa0, pa1, pa2, pa3);
}
__device__ __forceinline__ void attn_dense_body(const bf16_t* __restrict__ Qb, const bf16_t* __restrict__ Kh, const bf16_t* __restrict__ Vh,
                                                bf16_t* __restrict__ Ob, int seq, char* lds) {
  const int tid = opaque_tid(), wid = tid >> 6, lane = tid & 63, r32 = lane & 31, hi = lane >> 5;
  bf16_t* V_lds = (bf16_t*)lds; bf16_t* K_lds = (bf16_t*)(lds + 2 * SHM_V);
  float* ws = (float*)(lds + 2 * SHM_V + 2 * SHM_K) + wid * 64; float* li_l = ws; float* al_l = ws + 32;
  float m_reg = -1e30f, l_reg = 0; f32x16 o[4] = {}; bf16x8 qr[8];
  const bf16_t* Qw = Qb + (long)(wid * QBLK + r32) * LDQ + hi * 8;
#pragma unroll
  for (int d0 = 0; d0 < 8; ++d0) qr[d0] = *reinterpret_cast<const bf16x8*>(Qw + d0 * 16);
  const int sr = tid >> 4, sc = (tid & 15) * 8, vst0 = v_st(sr, sc), vst1 = v_st(32 + sr, sc);
  const int vb0 = (int)(uintptr_t)V_lds + v_rd_base(lane);
  struct { bf16x8 vs0, vs1, ks0, ks1; } sr_[2];
#define SLOAD(i, k0) do { sr_[i].vs0 = *reinterpret_cast<const bf16x8*>(&Vh[(long)((k0) + sr) * LDK + sc]); sr_[i].vs1 = *reinterpret_cast<const bf16x8*>(&Vh[(long)((k0) + 32 + sr) * LDK + sc]); \
    sr_[i].ks0 = *reinterpret_cast<const bf16x8*>(&Kh[(long)((k0) + sr) * LDK + sc]); sr_[i].ks1 = *reinterpret_cast<const bf16x8*>(&Kh[(long)((k0) + 32 + sr) * LDK + sc]); } while (0)
#define SWRITE(b, i) do { *(bf16x8*)((char*)V_lds + (b) * SHM_V + vst0) = sr_[i].vs0;          \
    *(bf16x8*)((char*)V_lds + (b) * SHM_V + vst1) = sr_[i].vs1; int kc = sc * 2;               \
    *(bf16x8*)((char*)K_lds + (b) * SHM_K + KSWZ(sr, kc)) = sr_[i].ks0;                       \
    *(bf16x8*)((char*)K_lds + (b) * SHM_K + KSWZ(32 + sr, kc)) = sr_[i].ks1; } while (0)
#define SWAIT() asm volatile("s_waitcnt vmcnt(4)" ::: "memory")
#define RESC(a) do { if (__any((a) < 1.f)) { if (hi == 0) al_l[r32] = (a); asm volatile("s_waitcnt lgkmcnt(0)" ::: "memory"); \
    for (int d = 0; d < 4; ++d) for (int r = 0; r < 16; ++r) o[d][r] *= al_l[crow(r, hi)]; } } while (0)
  f32x16 pA0, pA1, pB0, pB1; float mnA, mnB, alA, alB; bf16x8 pa0, pa1, pa2, pa3; const int NT = seq / KVBLK;
  constexpr int SE = 0, SO = 1;
  SLOAD(SE, 0); asm volatile("s_waitcnt vmcnt(0)" ::: "memory"); SWRITE(0, SE); __syncthreads();
  qkt(pA0, pA1, K_lds, qr, r32, hi); partialSM(pA0, pA1, m_reg, mnA, alA);
  SLOAD(SO, KVBLK); if (2 < NT) SLOAD(SE, 2 * KVBLK);
  SWAIT(); SWRITE(1, SO); __syncthreads();
  for (int j = 1; j + 1 < NT; j += 2) {
    SBAR(); qkt(pB0, pB1, (bf16_t*)((char*)K_lds + SHM_K), qr, r32, hi);
    finishSM(pA0, pA1, alA, l_reg, pa0, pa1, pa2, pa3); SBAR();
    SLOAD(SO, (j + 2) * KVBLK); SBAR();
    pv_d0(o, vb0, pa0, pa1, pa2, pa3); partialSM(pB0, pB1, m_reg, mnB, alB);
    __syncthreads(); SWAIT(); SWRITE(0, SE);
    RESC(alB); __syncthreads();
    SBAR(); qkt(pA0, pA1, K_lds, qr, r32, hi);
    finishSM(pB0, pB1, alB, l_reg, pa0, pa1, pa2, pa3); SBAR();
    if (j + 3 < NT) SLOAD(SE, (j + 3) * KVBLK); SBAR();
    pv_d0(o, vb0 + (int)SHM_V, pa0, pa1, pa2, pa3); partialSM(pA0, pA1, m_reg, mnA, alA);
    __syncthreads(); SWAIT(); SWRITE(1, SO);
    RESC(alA); __syncthreads();
  }
  SBAR(); qkt(pB0, pB1, (bf16_t*)((char*)K_lds + SHM_K), qr, r32, hi);
  finishSM(pA0, pA1, alA, l_reg, pa0, pa1, pa2, pa3); SBAR();
  pv_d0(o, vb0, pa0, pa1, pa2, pa3); partialSM(pB0, pB1, m_reg, mnB, alB);
  __syncthreads(); RESC(alB);
  finishSM(pB0, pB1, alB, l_reg, pa0, pa1, pa2, pa3); SBAR();
  pv_d0(o, vb0 + (int)SHM_V, pa0, pa1, pa2, pa3);
  if (hi == 0) li_l[r32] = l_reg; asm volatile("s_waitcnt lgkmcnt(0)" ::: "memory");
  float rli[16];
#pragma unroll
  for (int r = 0; r < 16; ++r) rli[r] = __builtin_amdgcn_rcpf(li_l[crow(r, hi)]);
  bf16_t* Ow = Ob + (long)(wid * QBLK) * LDO;
#pragma unroll
  for (int r = 0; r < 16; ++r) { int orow = crow(r, hi);
#pragma unroll
    for (int d0 = 0; d0 < 4; ++d0) { const float v = o[d0][r] * rli[r]; Ow[(long)orow * LDO + d0 * 32 + r32] = (bf16_t)(cvtpk(v, v) & 0xffffu); } }
#undef SLOAD
#undef SWRITE
#undef SWAIT
#undef RESC
}
}

__device__ __forceinline__ int up_row(int n) { const int n2 = n >= DFF ? n - DFF : n; return 8 * (n2 >> 2) + (n2 & 3) + (n >= DFF ? 4 : 0); }
__device__ __forceinline__ int qkv_row(int n) { const int d = n & 127, a = d >> 6, nn = (d >> 5) & 1, pp = d & 31; return (n & ~127) + 8 * ((32 * a + pp) >> 2) + 4 * nn + (pp & 3); }
__device__ __forceinline__ void transpose_item(const float* W, int K, int N, bf16_t* WT, int rmap, LAS float* scr, int item, int lane) {
    const int nblk = N / 32, kb = item / nblk, nb = item % nblk, k0 = 64 * kb, n0 = 32 * nb;
    float tv[32];
    const float* wp = W + (size_t)(k0 + (lane >> 5)) * N + n0 + (lane & 31);
#pragma unroll
    for (int i = 0; i < 32; ++i) tv[i] = wp[(size_t)(2 * i) * N];
#pragma unroll
    for (int i = 0; i < 32; ++i) scr[(2 * i + (lane >> 5)) * 33 + (lane & 31)] = tv[i];
    asm volatile("s_waitcnt lgkmcnt(0)" ::: "memory");
    const int c = lane & 7;
#pragma unroll
    for (int j = 0; j < 4; ++j) { const int n = (lane >> 3) + 8 * j; const LAS float* s = scr + (8 * c) * 33 + n;
        u32x4 o; o.x = cvt_pk_bf16(s[0 * 33], s[1 * 33]); o.y = cvt_pk_bf16(s[2 * 33], s[3 * 33]); o.z = cvt_pk_bf16(s[4 * 33], s[5 * 33]); o.w = cvt_pk_bf16(s[6 * 33], s[7 * 33]);
        const int dr = rmap == 1 ? up_row(n0 + n) : (rmap == 2 ? qkv_row(n0 + n) : (n0 + n));
        *(u32x4*)(WT + (size_t)dr * K + k0 + 8 * c) = o; }
    asm volatile("s_waitcnt lgkmcnt(0)" ::: "memory");
}

__device__ __forceinline__ void convert_layer_weights(int l, int widx, int nw, LAS unsigned char* lds) {
    const Params p = kparams(); unsigned char* ws = p.ws;
    const int tid = opaque_tid(), lane = tid & 63, wave = __builtin_amdgcn_readfirstlane(tid >> 6);
    LAS float* scr = (LAS float*)(lds + 65536 + wave * 8704);
    constexpr int I_QKV = 16 * 48, I_O = 16 * 32, I_PL = 4 * 8, I_UP = 16 * 176, I_DN = 44 * 32;
    const int nmix = (l & 1) ? 4 * I_PL : I_QKV + I_O, nitems = I_UP + I_DN + nmix, a = l >> 1;
    for (int it = widx; it < nitems; it += nw) {
        int r = it; const float* W; bf16_t* WT; int K, N, sub; int upm = 0;
        if (r < I_UP) { sub = r; W = p.w_up + (size_t)l * DM * 2 * DFF; K = DM; N = 2 * DFF; WT = (bf16_t*)(ws + WS_WUP) + (size_t)l * 2 * DFF * DM; upm = 1; }
        else if ((r -= I_UP) < I_DN) { sub = r; W = p.w_down + (size_t)l * DFF * DM; K = DFF; N = DM; WT = (bf16_t*)(ws + WS_WDN) + (size_t)l * DM * DFF; }
        else if (l & 1) { r -= I_DN; const int pg = a * 4 + r / I_PL; sub = r % I_PL; W = p.w_pool + (size_t)pg * 65536; K = 256; N = 256; WT = (bf16_t*)(ws + WS_WPOOL) + (size_t)pg * 65536; }
        else if ((r -= I_DN) < I_QKV) { sub = r; W = p.w_qkv + (size_t)a * DM * QKVW; K = DM; N = QKVW; WT = (bf16_t*)(ws + WS_WQKV) + (size_t)a * QKVW * DM; upm = 2; }
        else { sub = r - I_QKV; W = p.w_o + (size_t)a * DM * DM; K = DM; N = DM; WT = (bf16_t*)(ws + WS_WO) + (size_t)a * DM * DM; }
        transpose_item(W, K, N, WT, upm, scr, sub, lane);
    }
}

__device__ __forceinline__ void mod_items(int item_begin, int item_end, int bidx, int nblk, LAS unsigned char* lds) {
    const Params p = kparams();
    const int tid = opaque_tid();
    LAS float* sil = (LAS float*)lds;
    LAS float* red = (LAS float*)(lds + 20480);
    if (item_begin + bidx >= item_end) return;
    for (int i = tid; i < 5 * DM; i += 512) { const int cnd = i >> 10, k = i & 1023; const float v = cnd == 0 ? p.c_ctx[k] : p.c[(cnd - 1) * DM + k]; sil[i] = silu_f(v); }
    __syncthreads();
    float* modo = (float*)(p.ws + WS_MOD);
    for (int item = item_begin + bidx; item < item_end; item += nblk) {
        const int l = item / 192, col0 = (item % 192) * 32, cgp = tid & 7, kr = tid >> 3;
        f32x4 acc[5];
#pragma unroll
        for (int cnd = 0; cnd < 5; ++cnd) acc[cnd] = (f32x4){0.f, 0.f, 0.f, 0.f};
        const float* wp = p.w_ada + ((size_t)l * DM + kr) * NMODW + col0 + 4 * cgp;
        f32x4 w4[16];
#pragma unroll
        for (int i = 0; i < 16; ++i) w4[i] = *(const f32x4*)(wp + (size_t)i * 64 * NMODW);
#pragma unroll
        for (int i = 0; i < 16; ++i) { const int k = kr + 64 * i;
#pragma unroll
            for (int cnd = 0; cnd < 5; ++cnd) acc[cnd] += w4[i] * sil[cnd * DM + k]; }
#pragma unroll
        for (int cnd = 0; cnd < 5; ++cnd) *(LAS f32x4*)(red + (kr * 5 + cnd) * 32 + 4 * cgp) = acc[cnd];
        __syncthreads();
        if (tid < 160) { const int cnd = tid >> 5, col = tid & 31; float s = 0.f;
#pragma unroll 8
            for (int k2 = 0; k2 < 64; ++k2) s += red[(k2 * 5 + cnd) * 32 + col];
            modo[(size_t)(l * 5 + cnd) * NMODW + col0 + col] = s + p.b_ada[l * NMODW + col0 + col]; }
        __syncthreads();
    }
}

__device__ __forceinline__ void prep_phase(LAS unsigned char* lds) {
    const Params p = kparams();
    const int tid = opaque_tid(), lane = tid & 63, wave = __builtin_amdgcn_readfirstlane(tid >> 6), G = gridDim.x, gw = blockIdx.x * NWAVES + wave, NGW = G * NWAVES; (void)tid; (void)lane; (void)wave; (void)gw; (void)NGW; (void)G;
    unsigned char* ws = p.ws;
    convert_layer_weights(0, gw, NGW, lds);
    for (int it = gw; it < 2 * 4 * PAST; it += NGW) {
        const int alx = it >> 11, idx = it & 2047, b = idx >> 9, pp = idx & (PAST - 1);
        const size_t srco = ((size_t)(b * 2 + alx) * PAST + pp) * KVW + lane * 4, dst = ((size_t)b * KV_S + SEQ_S + pp) * KVW + lane * 4;
        const f32x4 kv = *(const f32x4*)(p.cache_k + srco), vv = *(const f32x4*)(p.cache_v + srco);
        u32x2 wk, wv; wk.x = cvt_pk_bf16(kv[0], kv[1]); wk.y = cvt_pk_bf16(kv[2], kv[3]); wv.x = cvt_pk_bf16(vv[0], vv[1]); wv.y = cvt_pk_bf16(vv[2], vv[3]);
        *(u32x2*)((bf16_t*)(ws + WS_KS + (size_t)alx * KVS_LAYER) + dst) = wk; *(u32x2*)((bf16_t*)(ws + WS_VS + (size_t)alx * KVS_LAYER) + dst) = wv;
    }
}

__device__ __forceinline__ void rowpass(const float* xsrc_p, const float* xsrc_s, float* xdst, const float* yraw,
                                        const float* modg, int gate_idx, const float* g_post, const float* modh, int shift_idx, const float* g_pre, bf16_t* H, bf16_t* X16) {
    const int tid = opaque_tid(), lane = tid & 63, wave = __builtin_amdgcn_readfirstlane(tid >> 6), G = gridDim.x, gw = blockIdx.x * NWAVES + wave, NGW = G * NWAVES; (void)tid; (void)lane; (void)wave; (void)gw; (void)NGW; (void)G;
    for (int r0 = gw * 8; r0 < NTOK; r0 += NGW * 8) {
        const int cond = r0 < NP ? 0 : 1 + ((r0 - NP) >> 11);
        f32x4 Gv[4], Av[4], Bv[4];
#pragma unroll
        for (int j = 0; j < 4; ++j) { const int col = 4 * lane + 256 * j;
            Gv[j] = (f32x4){0.f, 0.f, 0.f, 0.f}; Av[j] = Gv[j]; Bv[j] = Gv[j];
            if (yraw) Gv[j] = *(const f32x4*)(modg + (size_t)cond * NMODW + gate_idx * DM + col) * *(const f32x4*)(g_post + col);
            if (H) { const f32x4 sh = *(const f32x4*)(modh + (size_t)cond * NMODW + shift_idx * DM + col), scl = *(const f32x4*)(modh + (size_t)cond * NMODW + (shift_idx + 1) * DM + col);
                Av[j] = *(const f32x4*)(g_pre + col) * (scl + 1.0f); Bv[j] = sh; } }
#pragma unroll 4
        for (int i = 0; i < 8; ++i) { const int row = r0 + i;
            const float* xr = row < NP ? xsrc_p + (size_t)row * DM : xsrc_s + (size_t)(row - NP) * DM;
            f32x4 v[4];
#pragma unroll
            for (int j = 0; j < 4; ++j) v[j] = *(const f32x4*)(xr + 4 * lane + 256 * j);
            if (yraw) { f32x4 y[4]; float ss = 0.f;
#pragma unroll
                for (int j = 0; j < 4; ++j) { y[j] = *(const f32x4*)(yraw + (size_t)row * DM + 4 * lane + 256 * j); ss += (y[j][0] * y[j][0] + y[j][1] * y[j][1]) + (y[j][2] * y[j][2] + y[j][3] * y[j][3]); }
                const float rs = 1.0f / sqrtf(wave_sum(ss) * (1.0f / DM) + EPS);
#pragma unroll
                for (int j = 0; j < 4; ++j) v[j] += Gv[j] * (y[j] * rs); }
            if (xdst) {
#pragma unroll
                for (int j = 0; j < 4; ++j) *(f32x4*)(xdst + (size_t)row * DM + 4 * lane + 256 * j) = v[j]; }
            if (X16) {
#pragma unroll
                for (int j = 0; j < 4; ++j) { u32x2 w; w.x = cvt_pk_bf16(v[j][0], v[j][1]); w.y = cvt_pk_bf16(v[j][2], v[j][3]); *(u32x2*)(X16 + (size_t)row * DM + 4 * lane + 256 * j) = w; } }
            if (H) { float ss = 0.f;
#pragma unroll
                for (int j = 0; j < 4; ++j) ss += (v[j][0] * v[j][0] + v[j][1] * v[j][1]) + (v[j][2] * v[j][2] + v[j][3] * v[j][3]);
                const float rs = 1.0f / sqrtf(wave_sum(ss) * (1.0f / DM) + EPS);
#pragma unroll
                for (int j = 0; j < 4; ++j) { const f32x4 h = (v[j] * rs) * Av[j] + Bv[j]; u32x2 w; w.x = cvt_pk_bf16(h[0], h[1]); w.y = cvt_pk_bf16(h[2], h[3]);
                    *(u32x2*)(H + (size_t)row * DM + 4 * lane + 256 * j) = w; } }
        }
    }
}

template <int GI> __device__ __forceinline__ void pool_item(const bf16_t* H, bf16_t* P, int chunk, int lane) {
    constexpr int half = 1 << GI, NR = 31 + 2 * half;
    const int t0 = chunk * 32;
    int ss, T; if (t0 < NP) { ss = t0 & ~(SEQ_P - 1); T = SEQ_P; } else { ss = NP + ((t0 - NP) & ~(SEQ_S - 1)); T = SEQ_S; }
    const int tl0 = t0 - ss;
    const bf16_t* base = H + (size_t)ss * DM + GI * 256 + lane * 4;
    u32x2 v[NR];
#pragma unroll
    for (int i = 0; i < NR; ++i) { const int rl = tl0 - half + i; const bool ok = (rl >= 0) && (rl < T); const u32x2 x = *(const u32x2*)(base + (size_t)(ok ? rl : tl0) * DM); v[i].x = ok ? x.x : 0u; v[i].y = ok ? x.y : 0u; }
    f32x4 S = (f32x4){0.f, 0.f, 0.f, 0.f};
#pragma unroll
    for (int i = 0; i < 2 * half; ++i) { S[0] += bf_lo(v[i].x); S[1] += bf_hi(v[i].x); S[2] += bf_lo(v[i].y); S[3] += bf_hi(v[i].y); }
    bf16_t* out = P + (size_t)t0 * DM + GI * 256 + lane * 4;
#pragma unroll
    for (int j = 0; j < 32; ++j) { const int tl = tl0 + j; const int lo = tl - half < 0 ? 0 : tl - half, hi = tl + half > T ? T : tl + half; const float inv = 1.0f / (float)(hi - lo);
        const u32x2 c = v[j + half]; u32x2 w; w.x = cvt_pk_bf16(S[0] * inv - bf_lo(c.x), S[1] * inv - bf_hi(c.x)); w.y = cvt_pk_bf16(S[2] * inv - bf_lo(c.y), S[3] * inv - bf_hi(c.y));
        *(u32x2*)(out + (size_t)j * DM) = w;
        if (j < 31) { const u32x2 a = v[j + 2 * half], d = v[j]; S[0] += bf_lo(a.x) - bf_lo(d.x); S[1] += bf_hi(a.x) - bf_hi(d.x); S[2] += bf_lo(a.y) - bf_lo(d.y); S[3] += bf_hi(a.y) - bf_hi(d.y); } }
}
template <int GI> __device__ __forceinline__ void pool_item_x(const bf16_t* X16, const float* RS, f32x4 Av, bf16_t* P, int chunk, int lane) {
    constexpr int half = 1 << GI, NR = 31 + 2 * half;
    const int t0 = chunk * 32;
    int ss, T; if (t0 < NP) { ss = t0 & ~(SEQ_P - 1); T = SEQ_P; } else { ss = NP + ((t0 - NP) & ~(SEQ_S - 1)); T = SEQ_S; }
    const int tl0 = t0 - ss;
    const bf16_t* base = X16 + (size_t)ss * DM + GI * 256 + lane * 4;
    u32x2 v[NR]; float rv[NR];
#pragma unroll
    for (int i = 0; i < NR; ++i) { const int rl = tl0 - half + i; const bool ok = (rl >= 0) && (rl < T); const int rc = ok ? rl : tl0;
        const u32x2 x = *(const u32x2*)(base + (size_t)rc * DM); v[i].x = ok ? x.x : 0u; v[i].y = ok ? x.y : 0u; rv[i] = RS[ss + rc]; }
#define XH(i) ((f32x4){bf_lo(v[i].x), bf_hi(v[i].x), bf_lo(v[i].y), bf_hi(v[i].y)} * rv[i])
    f32x4 S = (f32x4){0.f, 0.f, 0.f, 0.f};
#pragma unroll
    for (int i = 0; i < 2 * half; ++i) S += XH(i);
    bf16_t* out = P + (size_t)t0 * DM + GI * 256 + lane * 4;
#pragma unroll
    for (int j = 0; j < 32; ++j) { const int tl = tl0 + j; const int lo = tl - half < 0 ? 0 : tl - half, hi = tl + half > T ? T : tl + half; const float inv = 1.0f / (float)(hi - lo);
        const f32x4 o = Av * (S * inv - XH(j + half)); u32x2 w; w.x = cvt_pk_bf16(o[0], o[1]); w.y = cvt_pk_bf16(o[2], o[3]);
        *(u32x2*)(out + (size_t)j * DM) = w;
        if (j < 31) S += XH(j + 2 * half) - XH(j); }
#undef XH
}
__device__ __forceinline__ void pool_local(int l, bf16_t* P, int pm, int pn) {
    const Params p = kparams();
    const int tid = opaque_tid(), lane = tid & 63, wave = __builtin_amdgcn_readfirstlane(tid >> 6);
    const int chunk = pm * 8 + wave, rowt = pm * 256, cond = rowt < NP ? 0 : 1 + ((rowt - NP) >> 11), col = pn * 256 + lane * 4;
    const float* mod = (const float*)(p.ws + WS_MOD) + ((size_t)l * 5 + cond) * NMODW;
    const f32x4 Av = *(const f32x4*)(p.norm_gains + (size_t)(l * 4) * DM + col) * (*(const f32x4*)(mod + DM + col) + 1.0f);
    const bf16_t* X16 = (const bf16_t*)(p.ws + WS_X16 + (l == 3 ? X16_COPY : 0)); const float* RS = (const float*)(p.ws + WS_RS);
    if (pn == 0) pool_item_x<0>(X16, RS, Av, P, chunk, lane); else if (pn == 1) pool_item_x<1>(X16, RS, Av, P, chunk, lane); else if (pn == 2) pool_item_x<2>(X16, RS, Av, P, chunk, lane); else pool_item_x<3>(X16, RS, Av, P, chunk, lane);
    asm volatile("s_waitcnt vmcnt(0)" ::: "memory");
    __builtin_amdgcn_fence(__ATOMIC_ACQUIRE, "agent");
    asm volatile("s_waitcnt vmcnt(0)" ::: "memory");
    __syncthreads();
}
__device__ __forceinline__ void pool_pass(const bf16_t* H, bf16_t* P) {
    const int tid = opaque_tid(), lane = tid & 63, wave = __builtin_amdgcn_readfirstlane(tid >> 6), gw = blockIdx.x * NWAVES + wave, NGW = gridDim.x * NWAVES;
    for (int it = gw; it < (NTOK / 32) * 4; it += NGW) { const int chunk = it >> 2, g = it & 3;
        if (g == 0) pool_item<0>(H, P, chunk, lane); else if (g == 1) pool_item<1>(H, P, chunk, lane); else if (g == 2) pool_item<2>(H, P, chunk, lane); else pool_item<3>(H, P, chunk, lane); }
}

__device__ __forceinline__ void attn_phase(char* lds, int G, int al) {
    const Params p = kparams();
    unsigned char* ws = p.ws;
    const bf16_t* qkv = (const bf16_t*)(ws + WS_QKV); const bf16_t* Kp = (const bf16_t*)(ws + WS_KP); const bf16_t* Ks = (const bf16_t*)(ws + WS_KS + (size_t)al * KVS_LAYER);
    const bf16_t* Vp = (const bf16_t*)(ws + WS_VP); const bf16_t* Vs = (const bf16_t*)(ws + WS_VS + (size_t)al * KVS_LAYER); bf16_t* AO = (bf16_t*)(ws + WS_ATTO);
#pragma unroll 1
    for (int u = vcu(); u < 512; u += G) {
        const bf16_t *Qb, *Kh, *Vh; bf16_t* Ob; int seq;
        if (u < 256) { const int combo = u & 7, b = combo >> 1, kvh = combo & 1, w = u >> 3, hq = kvh * 4 + (w >> 3), qb = w & 7;
            const size_t row0 = (size_t)NP + b * SEQ_S + qb * 256;
            Qb = qkv + row0 * DM + hq * 128; Kh = Ks + (size_t)b * KV_S * KVW + kvh * 128; Vh = Vs + (size_t)b * KV_S * KVW + kvh * 128; Ob = AO + row0 * DM + hq * 128; seq = KV_S; }
        else { const int u2 = u - 256, b = u2 >> 3, hq = u2 & 7, kvh = hq >> 2; const size_t row0 = (size_t)b * SEQ_P;
            Qb = qkv + row0 * DM + hq * 128; Kh = Kp + row0 * KVW + kvh * 128; Vh = Vp + row0 * KVW + kvh * 128; Ob = AO + row0 * DM + hq * 128; seq = SEQ_P; }
        attn::attn_dense_body(Qb, Kh, Vh, Ob, seq, lds);
        __syncthreads();
    }
}


#define XB_TMO      128
#define XB_XCNT(j)  (256  + 64 * (j))
#define XB_XSUB(j)  (1280 + 64 * (j))
#define XB_XGEN(j)  (2304 + 64 * (j))
#define XB_TOP      3328
#define XB_TOPGEN   3392
#define XCD_BAR_WORDS 3456
#define XB_SPIN_CAP (1u << 18)
__device__ __forceinline__ unsigned xb_ld(unsigned* p)              { return __hip_atomic_load(p, __ATOMIC_RELAXED, __HIP_MEMORY_SCOPE_AGENT); }
__device__ __forceinline__ unsigned xb_add(unsigned* p, unsigned v) { return __hip_atomic_fetch_add(p, v, __ATOMIC_RELAXED, __HIP_MEMORY_SCOPE_AGENT); }
__device__ __forceinline__ unsigned xb_xcc_id() { return (unsigned)__builtin_amdgcn_s_getreg((3 << 11) | 20) & 0xFu; }
#define XB_SPIN(cond, bar) do { unsigned _sp = 0; while (cond) { __builtin_amdgcn_s_sleep(1); \
    if ((++_sp & 255u) == 0u) { if (xb_ld(&(bar)[XB_TMO])) break; if (_sp > XB_SPIN_CAP) { atomicAdd(&(bar)[XB_TMO], 1u); break; } } } } while (0)
__device__ __forceinline__ void xcd_barrier_post(unsigned* bar, volatile LAS unsigned* misc) {
    if (opaque_tid() == 0) { const unsigned x = xb_xcc_id(); misc[16] = xb_add(&bar[XB_XCNT(x)], 1u); misc[17] = x; }
}
__device__ __forceinline__ void xcd_barrier_complete(unsigned* bar, unsigned x, unsigned& nloc, unsigned& nx) {
    const unsigned G = gridDim.x * gridDim.y * gridDim.z;
    unsigned sum, cnt, mine, sp = 0u;
    for (;;) {
        sum = 0u; cnt = 0u; mine = 0u;
#pragma unroll
        for (unsigned j = 0; j < 16; ++j) { const unsigned c = xb_ld(&bar[XB_XCNT(j)]); sum += c; cnt += (c > 0u) ? 1u : 0u; mine = (j == x) ? c : mine; }
        if (sum == G) break;
        __builtin_amdgcn_s_sleep(1);
        if ((++sp & 255u) == 0u) { if (xb_ld(&bar[XB_TMO])) break; if (sp > XB_SPIN_CAP) { atomicAdd(&bar[XB_TMO], 1u); break; } }
    }
    nloc = mine > 0u ? mine : 1u; nx = cnt > 0u ? cnt : 1u;
}
__device__ __forceinline__ bool xcd_census_uniform(unsigned* bar) {
    bool ok = (gridDim.x == 256);
#pragma unroll
    for (unsigned j = 0; j < 16; ++j) { const unsigned c = xb_ld(&bar[XB_XCNT(j)]); ok = ok && (j < 8u ? c == 32u : c == 0u); }
    return ok;
}
extern __shared__ __attribute__((aligned(16))) unsigned char lds_raw[];
constexpr int MISC_OFF = 147456 - 128;
__device__ __forceinline__ void xcd_barrier_now() {
    asm volatile("s_waitcnt vmcnt(0)" ::: "memory");
    __syncthreads();
    if (opaque_tid() == 0) {
        const Params kp = kparams();
        unsigned* bar = (unsigned*)kp.ws + CW_BAR; const unsigned x = xb_xcc_id();
        volatile LAS unsigned* st = (volatile LAS unsigned*)((LAS unsigned char*)lds_raw + MISC_OFF + 32);
        __builtin_amdgcn_s_waitcnt(0);
        unsigned nloc = st[0], nx = st[1];
        if (nloc == 0u) { xcd_barrier_complete(bar, x, nloc, nx); st[0] = nloc; st[1] = nx; st[10] = xcd_census_uniform(bar) ? 1u : 0u; }
        const unsigned old = xb_add(&bar[XB_XSUB(x)], 1u);
        const unsigned gen = old / nloc;
        if (old + 1u == (gen + 1u) * nloc) {
            __builtin_amdgcn_fence(__ATOMIC_RELEASE, "agent");
            asm volatile("s_waitcnt vmcnt(0)" ::: "memory");
            const unsigned og = xb_add(&bar[XB_TOP], 1u);
            const unsigned tg = og / nx;
            if (og + 1u == (tg + 1u) * nx) xb_add(&bar[XB_TOPGEN], 1u);
            else XB_SPIN(xb_ld(&bar[XB_TOPGEN]) == tg, bar);
            __builtin_amdgcn_fence(__ATOMIC_ACQUIRE, "agent");
            xb_add(&bar[XB_XGEN(x)], 1u);
            asm volatile("s_waitcnt vmcnt(0)" ::: "memory");
        } else {
            XB_SPIN(xb_ld(&bar[XB_XGEN(x)]) == gen, bar);
            __builtin_amdgcn_fence(__ATOMIC_ACQUIRE, "agent");
            asm volatile("s_waitcnt vmcnt(0)" ::: "memory");
        }
    }
    __syncthreads();
}


__device__ __forceinline__ bool census_uniform() { return ((volatile LAS unsigned*)((LAS unsigned char*)lds_raw + MISC_OFF))[18] != 0u; }
__device__ __forceinline__ int vcu() {
    volatile LAS unsigned* misc = (volatile LAS unsigned*)((LAS unsigned char*)lds_raw + MISC_OFF);
    const unsigned v = misc[18] != 0u ? misc[16] * 8u + misc[17] : blockIdx.x;
    return __builtin_amdgcn_readfirstlane((int)v);
}
__device__ __forceinline__ void xcc_barrier_now() {
    if (!census_uniform()) { xcd_barrier_now(); return; }
    asm volatile("s_waitcnt vmcnt(0)" ::: "memory");
    __syncthreads();
    if (opaque_tid() == 0) {
        const Params kp = kparams();
        unsigned* ctl = (unsigned*)kp.ws; unsigned* bar = ctl + CW_BAR; const unsigned x = xb_xcc_id();
        __builtin_amdgcn_s_waitcnt(0);
        const unsigned old = xb_add(&ctl[1024 + 64 * x], 1u);
        const unsigned gen = old / 32u;
        if (old + 1u == (gen + 1u) * 32u) xb_add(&ctl[2048 + 64 * x], 1u);
        else XB_SPIN(xb_ld(&ctl[2048 + 64 * x]) == gen, bar);
        __builtin_amdgcn_fence(__ATOMIC_ACQUIRE, "agent");
        asm volatile("s_waitcnt vmcnt(0)" ::: "memory");
    }
    __syncthreads();
}

__global__ void __launch_bounds__(NWAVES * 64, 2) mega_fwd(Params p_unused) {
    cg::grid_group grid = cg::this_grid();
    LAS unsigned char* lds = (LAS unsigned char*)lds_raw;
    const int G = gridDim.x;
    volatile LAS unsigned* MISC = (volatile LAS unsigned*)(lds + MISC_OFF);
    if (threadIdx.x < 32) MISC[threadIdx.x] = 0u;
    __syncthreads();
    { const Params p = kparams(); xcd_barrier_post((unsigned*)p.ws + CW_BAR, MISC); }

    { const Params p = kparams(); u32x4* z = (u32x4*)(p.ws + WS_XB1);
      for (int i = (int)blockIdx.x * (NWAVES * 64) + (int)threadIdx.x; i < (int)(2 * 524288 / 16); i += G * NWAVES * 64) z[i] = (u32x4){0u, 0u, 0u, 0u}; }
    mod_items(0, 192, (int)blockIdx.x, G, lds);
    if (gridDim.y == 12345u) grid.sync();
    xcd_barrier_now();
    { const Params p = kparams(); const float* mod = (const float*)(p.ws + WS_MOD);
      rowpass(p.x_prompt, p.x_sample, nullptr, nullptr, mod, 5, p.norm_gains, mod, 0, p.norm_gains, (bf16_t*)(p.ws + WS_H), (bf16_t*)(p.ws + WS_X16)); }
    prep_phase(lds);
    xcd_barrier_now();

    unsigned seq = 0;
#pragma unroll 1
    for (int l = 0; l < 4; ++l) {
        if ((l & 1) == 0) {
            const int al = l >> 1;
            { const Params p = kparams();
              pg8::Gemm g{(const bf16_t*)(p.ws + WS_H), (const bf16_t*)(p.ws + WS_WQKV) + (size_t)al * QKVW * DM, NTOK, QKVW, DM, DM, 0};
              pg8::StaticOrder S; S.init(NTOK, QKVW, G, vcu());
              pg8::EpiQKV E{al};
              pg8::gemm_phase<pg8::EpiQKV, pg8::StaticOrder, true>(lds, g, S, E);
            }
            if (l == 0) { const int R = (64 * 6) % G, nidle = R ? G - R : G, bi = R ? vcu() - R : vcu();
                if (bi >= 0) mod_items(192, 768, bi, nidle, lds); }
            xcd_barrier_now();
            attn_phase((char*)lds_raw, G, al);
            xcd_barrier_now();
        } else {
            const Params p = kparams();
            if (G == 256) { pg8::StaticOrder S; S.init(NTOK, DM, G, vcu()); pg8::Unit u; S.next(0, u);
                pool_local(l, (bf16_t*)(p.ws + WS_QKV), u.pm, u.pn); }
            else { pool_pass((const bf16_t*)(p.ws + WS_H), (bf16_t*)(p.ws + WS_QKV)); xcd_barrier_now(); }
        }
        { const Params p = kparams();
          pg8::Gemm gm;
          if ((l & 1) == 0) gm = pg8::Gemm{(const bf16_t*)(p.ws + WS_ATTO), (const bf16_t*)(p.ws + WS_WO) + (size_t)(l >> 1) * DM * DM, NTOK, DM, DM, DM, 0};
          else gm = pg8::Gemm{(const bf16_t*)(p.ws + WS_QKV), (const bf16_t*)(p.ws + WS_WPOOL) + (size_t)(l >> 1) * DM * 256, NTOK, DM, 256, DM, 256};
          pg8::StaticOrder S; S.init(NTOK, DM, G, vcu());
          pg8::EpiFused E{l, 0, 32u * (seq + 1u)}; ++seq;
          pg8::gemm_phase<pg8::EpiFused, pg8::StaticOrder, false>(lds, gm, S, E); }
        xcc_barrier_now();
        { const Params p = kparams();
          pg8::Gemm g{(const bf16_t*)(p.ws + WS_H), (const bf16_t*)(p.ws + WS_WUP) + (size_t)l * 2 * DFF * DM, NTOK, 2 * DFF, DM, DM, 0};
          pg8::StaticOrder S; S.init(NTOK, 2 * DFF, G, vcu());
          pg8::EpiSwiGLU E{(bf16_t*)(p.ws + WS_ACT)};
          pg8::gemm_phase<pg8::EpiSwiGLU, pg8::StaticOrder, true>(lds, g, S, E);
        }
        if (l < 3) { const int R = (64 * 22) % G, nidle = R ? G - R : G; const int bi = R ? vcu() - R : vcu();
            if (bi >= 0) convert_layer_weights(l + 1, bi * NWAVES + __builtin_amdgcn_readfirstlane(opaque_tid() >> 6), nidle * NWAVES, lds); }
        if (l < 3) xcd_barrier_now();
        else xcc_barrier_now();
        { const Params p = kparams();
          pg8::Gemm g{(const bf16_t*)(p.ws + WS_ACT), (const bf16_t*)(p.ws + WS_WDN) + (size_t)l * DM * DFF, NTOK, DM, DFF, DFF, 0};
          pg8::StaticOrder S; S.init(NTOK, DM, G, vcu());
          pg8::EpiFused E{l, 1, 32u * (seq + 1u)}; ++seq;
          pg8::gemm_phase<pg8::EpiFused, pg8::StaticOrder, false>(lds, g, S, E); }
        if (l < 3) xcc_barrier_now();
    }
}

extern "C" void kernel_launch(void* const* d_in, const int* in_sizes, int n_in, void* d_out, int out_size, void* d_ws, size_t ws_size, hipStream_t stream) {
    static int grid = 0;
    if (grid == 0) {
        if (n_in != 16 || ws_size < WS_END) { fprintf(stderr, "kernel_launch: unexpected n_in %d / ws_size %zu (need %zu)\n", n_in, ws_size, (size_t)WS_END); grid = -1; return; }
        int dev = 0, cus = 0, per_cu = 0;
        if (hipGetDevice(&dev) != hipSuccess || hipDeviceGetAttribute(&cus, hipDeviceAttributeMultiprocessorCount, dev) != hipSuccess) { grid = -1; return; }
        if (hipFuncSetAttribute((const void*)mega_fwd, hipFuncAttributeMaxDynamicSharedMemorySize, LDS_BYTES) != hipSuccess) { fprintf(stderr, "kernel_launch: hipFuncSetAttribute failed\n"); grid = -1; return; }
        if (hipOccupancyMaxActiveBlocksPerMultiprocessor(&per_cu, (const void*)mega_fwd, NWAVES * 64, LDS_BYTES) != hipSuccess || per_cu < 1) { fprintf(stderr, "kernel_launch: occupancy query says %d\n", per_cu); per_cu = 1; }
        (void)hipGetLastError();
        grid = cus;
    }
    if (grid < 0) return;
    if (hipMemsetAsync(d_ws, 0, CTL_ZERO_BYTES, stream) != hipSuccess) { fprintf(stderr, "kernel_launch: memset failed\n"); return; }
    Params p{};
    p.x_prompt = (const float*)d_in[0]; p.x_sample = (const float*)d_in[1]; p.c = (const float*)d_in[2]; p.cache_k = (const float*)d_in[3]; p.cache_v = (const float*)d_in[4];
    p.c_ctx = (const float*)d_in[5]; p.w_ada = (const float*)d_in[6]; p.b_ada = (const float*)d_in[7]; p.norm_gains = (const float*)d_in[8]; p.w_qkv = (const float*)d_in[9];
    p.qk_gains = (const float*)d_in[10]; p.w_o = (const float*)d_in[11]; p.w_pool = (const float*)d_in[12]; p.pool_scale = (const float*)d_in[13]; p.w_up = (const float*)d_in[14]; p.w_down = (const float*)d_in[15];
    p.out = (float*)d_out; p.ws = (unsigned char*)d_ws;
    void* args[] = {&p};
    const hipError_t e = hipLaunchCooperativeKernel((const void*)mega_fwd, dim3(grid), dim3(NWAVES * 64), args, LDS_BYTES, stream);
    if (e != hipSuccess) fprintf(stderr, "kernel_launch: cooperative launch failed: %s (grid %d)\n", hipGetErrorString(e), grid);
}
```

```cpp
#include <hip/hip_runtime.h>
#include <hip/hip_cooperative_groups.h>
#include <hip/hip_bf16.h>
#include <cstdio>
#include <cstdint>
namespace cg = cooperative_groups;

#define LAS __attribute__((address_space(3)))
typedef unsigned short bf16_t;
typedef short bf16x8 __attribute__((ext_vector_type(8)));
typedef short s16x4 __attribute__((ext_vector_type(4)));
typedef float f32x4 __attribute__((ext_vector_type(4)));
typedef float f32x16 __attribute__((ext_vector_type(16)));
typedef unsigned u32x4 __attribute__((ext_vector_type(4)));
typedef unsigned u32x2 __attribute__((ext_vector_type(2)));

constexpr int DM = 1024, NP = 8192, NS = 8192, NTOK = NP + NS, DFF = 2816, QKVW = 1536, NMODW = 6144;
constexpr int SEQ_P = 256, SEQ_S = 2048, PAST = 512, KV_S = SEQ_S + PAST, KVW = 256;
constexpr float EPS = 1e-6f;
constexpr int NWAVES = 8;

constexpr size_t MiB = 1u << 20;
constexpr size_t WS_WQKV = 1 * MiB;
constexpr size_t WS_WO = 7 * MiB;
constexpr size_t WS_WPOOL = 11 * MiB;
constexpr size_t WS_WUP = 12 * MiB;
constexpr size_t WS_WDN = 56 * MiB;
constexpr size_t WS_MOD = 78 * MiB;
constexpr size_t WS_H = 80 * MiB;
constexpr size_t WS_X16 = 112 * MiB;
constexpr size_t X16_COPY = 32 * MiB;
constexpr size_t WS_MIX = 176 * MiB;
constexpr size_t WS_QKV = WS_MIX;
constexpr size_t WS_KP = WS_MIX + 32 * MiB;
constexpr size_t WS_VP = WS_MIX + 36 * MiB;
constexpr size_t WS_ATTO = WS_MIX + 40 * MiB;
constexpr size_t WS_KS = WS_MIX + 72 * MiB;
constexpr size_t WS_VS = WS_MIX + 82 * MiB;
constexpr size_t WS_ACT = WS_MIX + 92 * MiB;
constexpr size_t KVS_LAYER = 5 * MiB;
constexpr size_t WS_END = WS_MIX + 180 * MiB;

constexpr size_t CTL_ZERO_BYTES = 65536; constexpr int CW_BAR = 4096, CW_SEAM = 8192;
constexpr size_t WS_XB1 = 79 * MiB, WS_XB2 = 79 * MiB + 524288;
constexpr size_t WS_RS = 655360;
constexpr int LDS_BYTES = 147456;

struct Params {
    const float *x_prompt, *x_sample, *c, *cache_k, *cache_v, *c_ctx, *w_ada, *b_ada, *norm_gains, *w_qkv, *qk_gains, *w_o, *w_pool, *pool_scale, *w_up, *w_down;
    float* out; unsigned char* ws;
};

typedef const __attribute__((address_space(4))) Params* KParamsPtr;
__device__ __forceinline__ Params kparams() {
    KParamsPtr q = (KParamsPtr)__builtin_amdgcn_kernarg_segment_ptr(); asm volatile("" : "+s"(q));
    Params p;
    p.x_prompt = q->x_prompt; p.x_sample = q->x_sample; p.c = q->c; p.cache_k = q->cache_k; p.cache_v = q->cache_v; p.c_ctx = q->c_ctx; p.w_ada = q->w_ada; p.b_ada = q->b_ada;
    p.norm_gains = q->norm_gains; p.w_qkv = q->w_qkv; p.qk_gains = q->qk_gains; p.w_o = q->w_o; p.w_pool = q->w_pool; p.pool_scale = q->pool_scale; p.w_up = q->w_up; p.w_down = q->w_down;
    p.out = q->out; p.ws = q->ws;
    return p;
}

__device__ __forceinline__ unsigned cvt_pk_bf16(float lo, float hi) { unsigned r; asm volatile("v_cvt_pk_bf16_f32 %0, %1, %2" : "=v"(r) : "v"(lo), "v"(hi)); return r; }
__device__ __forceinline__ float bf_lo(unsigned u) { return __uint_as_float(u << 16); }
__device__ __forceinline__ float bf_hi(unsigned u) { return __uint_as_float(u & 0xffff0000u); }

__device__ __forceinline__ float sum_xor16(float v) { auto r = __builtin_amdgcn_permlane16_swap(__float_as_uint(v), __float_as_uint(v), false, false); return __uint_as_float(r[0]) + __uint_as_float(r[1]); }
__device__ __forceinline__ float sum_xor32(float v) { auto r = __builtin_amdgcn_permlane32_swap(__float_as_uint(v), __float_as_uint(v), false, false); return __uint_as_float(r[0]) + __uint_as_float(r[1]); }
template <int CTRL> __device__ __forceinline__ float dpp_f(float v) { return __uint_as_float((unsigned)__builtin_amdgcn_update_dpp(0, (int)__float_as_uint(v), CTRL, 0xf, 0xf, true)); }
__device__ __forceinline__ float row16_sum(float v) { v += dpp_f<0x128>(v); v += dpp_f<0x124>(v); v += dpp_f<0x122>(v); v += dpp_f<0x121>(v); return v; }
__device__ __forceinline__ float wave_sum(float v) { return sum_xor32(sum_xor16(row16_sum(v))); }
__device__ __forceinline__ int opaque_tid() { int t = threadIdx.x; asm volatile("" : "+v"(t)); return t; }
__device__ __forceinline__ int vcu();
__device__ __forceinline__ float silu_f(float x) { return x / (1.0f + __expf(-x)); }

namespace pg8 {
constexpr int BM = 256, BK = 64, HALF = 128, HTB = HALF * BK * 2, STAGE_BYTES = 8 * HTB, NXCD = 8, WGM = 8;
__host__ __device__ __forceinline__ int lds_byte(int r, int c) { const int st = (r >> 4) * 2 + (c >> 5), rr = r & 15, cc = c & 31, ob = rr * 64 + cc * 2; return st * 1024 + (ob ^ (((ob >> 9) & 1) << 5)); }
__host__ __device__ __forceinline__ void stage_rc(int b, int& R, int& C) { const int st = b / 1024, sb = b % 1024, swz = sb ^ (((sb >> 9) & 1) << 5); R = (st >> 1) * 16 + swz / 64; C = (st & 1) * 32 + (swz % 64) / 2; }
__host__ __device__ __forceinline__ int perm32(int rho) { const int n = rho >> 4, i = rho & 15; return 8 * (i >> 2) + 4 * n + (i & 3); }

struct Unit { int pm, pn; };
struct Gemm { const bf16_t* A; const bf16_t* Bt; int M, N, K; int lda; int acol; };

struct StaticOrder {
    int nM, nN, nwg, G, c;
    __device__ void init(int M, int N, int G_, int c_) { nM = M / BM; nN = N / BM; nwg = nM * nN; G = G_; c = c_; }
    __device__ bool next(int i, Unit& u) const {
        const long L = (long)i * G + c; if (L >= nwg) return false;
        int wgid = (int)L; { const int q = nwg / NXCD, r = nwg % NXCD, xcd = wgid % NXCD, off = wgid / NXCD; wgid = (xcd < r ? xcd * (q + 1) : r * (q + 1) + (xcd - r) * q) + off; }
        const int nig = WGM * nN, gid = wgid / nig, fm = gid * WGM, gsz = (nM - fm) < WGM ? (nM - fm) : WGM;
        u.pm = fm + ((wgid % nig) % gsz); u.pn = (wgid % nig) / gsz; return true;
    }
};

struct EpiBf16 {
    static constexpr bool PERM = true, AFTER_DRAIN = false;
    bf16_t* O; int ldc;
    __device__ __forceinline__ void operator()(const f32x4 (&acc)[2][2][4][2], const Unit& u, int wr, int wc, int fr, int fq, LAS unsigned char* lds) const {
        const int row0 = u.pm * BM + wr * 64 + fr; const int col0 = u.pn * BM + wc * 32 + 8 * fq;
#pragma unroll
        for (int ai = 0; ai < 2; ++ai)
#pragma unroll
            for (int m = 0; m < 4; ++m) { bf16_t* rowp = O + (size_t)(row0 + ai * HALF + m * 16) * ldc + col0;
#pragma unroll
                for (int bj = 0; bj < 2; ++bj) { const f32x4 v0 = acc[ai][bj][m][0], v1 = acc[ai][bj][m][1];
                    u32x4 w; w.x = cvt_pk_bf16(v0[0], v0[1]); w.y = cvt_pk_bf16(v0[2], v0[3]); w.z = cvt_pk_bf16(v1[0], v1[1]); w.w = cvt_pk_bf16(v1[2], v1[3]);
                    *(u32x4*)(rowp + bj * HALF) = w; } }
    }
};

template <int KIND, bool SMP>
__device__ __forceinline__ void qkv_body(const f32x4 (&acc)[2][2][4][2], const LAS float* XS, bf16_t* dst, int dstride, float* onew, int rl0, int ntok0, int a, f32x4 g1, f32x4 g2, f32x4 inv) {
#pragma unroll
    for (int ai = 0; ai < 2; ++ai)
#pragma unroll
        for (int m = 0; m < 4; ++m) { const int rl = ai * HALF + rl0 + m * 16;
            f32x4 cs, sn;
            if (SMP && KIND < 2) { const int ntok = ntok0 + rl; const float pos = (float)(a == 0 ? (ntok >> 6) : (ntok & 63));
#pragma unroll
                for (int j = 0; j < 4; ++j) { const float rev = __builtin_amdgcn_fractf(pos * inv[j]); sn[j] = __builtin_amdgcn_sinf(rev); cs[j] = __builtin_amdgcn_cosf(rev); } }
#pragma unroll
            for (int bj = 0; bj < 2; ++bj) { f32x4 o1 = acc[ai][bj][m][0], o2 = acc[ai][bj][m][1];
                if (KIND < 2) { const f32x4 ps = *(const LAS f32x4*)(XS + (rl * 2 + bj) * 4); const float rs = __builtin_amdgcn_rsqf(((ps[0] + ps[1]) + (ps[2] + ps[3])) * (1.0f / 128.0f) + 1e-6f);
                    const f32x4 y1 = o1 * rs * g1, y2 = o2 * rs * g2;
                    if (SMP) { o1 = y1 * cs - y2 * sn; o2 = y2 * cs + y1 * sn; } else { o1 = y1; o2 = y2; } }
                u32x2 w1, w2; w1.x = cvt_pk_bf16(o1[0], o1[1]); w1.y = cvt_pk_bf16(o1[2], o1[3]); w2.x = cvt_pk_bf16(o2[0], o2[1]); w2.y = cvt_pk_bf16(o2[2], o2[3]);
                bf16_t* d = dst + rl * dstride + bj * 128; *(u32x2*)d = w1; *(u32x2*)(d + 32) = w2;
                if (KIND > 0 && !SMP) { float* o = onew + rl * 256 + bj * 128; *(f32x4*)o = o1; *(f32x4*)(o + 32) = o2; }
            }
            asm volatile("" ::: "memory"); __builtin_amdgcn_sched_barrier(0);
        }
}
struct EpiQKV {
    static constexpr bool PERM = true, AFTER_DRAIN = false;
    int al;
    __device__ __forceinline__ void operator()(const f32x4 (&acc)[2][2][4][2], const Unit& u, int wr, int wc, int fr, int fq, LAS unsigned char* lds) const {
        const Params kp = kparams();
        LAS float* XS = (LAS float*)(lds + STAGE_BYTES);
        const int pn = u.pn, rowt = u.pm * BM, rl0 = wr * 64 + fr;
        if (pn < 5) {
#pragma unroll
            for (int ai = 0; ai < 2; ++ai)
#pragma unroll
                for (int m = 0; m < 4; ++m)
#pragma unroll
                    for (int bj = 0; bj < 2; ++bj) { const f32x4 a0 = acc[ai][bj][m][0], a1 = acc[ai][bj][m][1];
                        float s = ((a0[0] * a0[0] + a0[1] * a0[1]) + (a0[2] * a0[2] + a0[3] * a0[3])) + ((a1[0] * a1[0] + a1[1] * a1[1]) + (a1[2] * a1[2] + a1[3] * a1[3]));
                        s = sum_xor32(sum_xor16(s));
                        if (fq == 0) XS[((ai * HALF + rl0 + m * 16) * 2 + bj) * 4 + wc] = s; }
        }
        asm volatile("s_waitcnt lgkmcnt(0)" ::: "memory"); __builtin_amdgcn_s_barrier(); asm volatile("" ::: "memory");
        const bool smp = rowt >= 8192;
        const int a = wc >> 1, pp0 = 16 * (wc & 1) + 4 * fq, d0 = 64 * a + pp0;
        f32x4 g1 = (f32x4){1.f, 1.f, 1.f, 1.f}, g2 = g1, inv = g1;
        if (pn < 5) { const float* gq = kp.qk_gains + (size_t)(al * 2 + (pn < 4 ? 0 : 1)) * 128; g1 = *(const f32x4*)(gq + d0); g2 = *(const f32x4*)(gq + d0 + 32);
#pragma unroll
            for (int j = 0; j < 4; ++j) inv[j] = __builtin_amdgcn_exp2f(-(float)(pp0 + j) * (13.287712379549449f / 32.0f)) * 0.15915494309189535f; }
        const int ntok0 = (rowt - 8192) & 2047, bs = (rowt - 8192) >> 11;
        if (pn < 4) { bf16_t* dst = (bf16_t*)(kp.ws + WS_QKV) + (size_t)rowt * 1024 + 2 * pn * 128 + d0;
            if (smp) qkv_body<0, true>(acc, XS, dst, 1024, nullptr, rl0, ntok0, a, g1, g2, inv); else qkv_body<0, false>(acc, XS, dst, 1024, nullptr, rl0, ntok0, a, g1, g2, inv); }
        else { const bool isv = pn == 5;
            bf16_t* dst = smp ? (bf16_t*)(kp.ws + (isv ? WS_VS : WS_KS) + (size_t)al * KVS_LAYER) + ((size_t)bs * 2560 + ntok0) * 256 + d0 : (bf16_t*)(kp.ws + (isv ? WS_VP : WS_KP)) + (size_t)rowt * 256 + d0;
            float* onew = kp.out + (size_t)16384 * 1024 + (isv ? (size_t)32 * 2 * 256 * 256 : 0) + (size_t)((rowt >> 8) * 2 + al) * 65536 + d0;
            if (!isv) { if (smp) qkv_body<1, true>(acc, XS, dst, 256, onew, rl0, ntok0, a, g1, g2, inv); else qkv_body<1, false>(acc, XS, dst, 256, onew, rl0, ntok0, a, g1, g2, inv); }
            else { if (smp) qkv_body<2, true>(acc, XS, dst, 256, onew, rl0, ntok0, a, g1, g2, inv); else qkv_body<2, false>(acc, XS, dst, 256, onew, rl0, ntok0, a, g1, g2, inv); } }
    }
};
struct EpiSwiGLU {
    static constexpr bool PERM = true, AFTER_DRAIN = false;
    bf16_t* O;
    __device__ __forceinline__ void operator()(const f32x4 (&acc)[2][2][4][2], const Unit& u, int wr, int wc, int fr, int fq, LAS unsigned char* lds) const {
        const int row0 = u.pm * BM + wr * 64 + fr; const int col0 = u.pn * 128 + wc * 16 + 4 * fq;
#pragma unroll
        for (int ai = 0; ai < 2; ++ai)
#pragma unroll
            for (int m = 0; m < 4; ++m) { bf16_t* rowp = O + (size_t)(row0 + ai * HALF + m * 16) * DFF + col0;
#pragma unroll
                for (int bj = 0; bj < 2; ++bj) { const f32x4 g = acc[ai][bj][m][0], up = acc[ai][bj][m][1]; f32x4 v;
#pragma unroll
                    for (int j = 0; j < 4; ++j) v[j] = g[j] * __builtin_amdgcn_rcpf(1.0f + __builtin_amdgcn_exp2f(-1.4426950408889634f * g[j])) * up[j];
                    u32x2 w; w.x = cvt_pk_bf16(v[0], v[1]); w.y = cvt_pk_bf16(v[2], v[3]);
                    *(u32x2*)(rowp + bj * 64) = w; } }
    }
};
struct EpiF32 {
    static constexpr bool PERM = false, AFTER_DRAIN = false;
    float* O; int ldc; const float* colscale;
    __device__ __forceinline__ void operator()(const f32x4 (&acc)[2][2][4][2], const Unit& u, int wr, int wc, int fr, int fq, LAS unsigned char* lds) const {
        const int row0 = u.pm * BM + wr * 64 + fr; const int col0 = u.pn * BM + wc * 32 + 4 * fq;
#pragma unroll
        for (int bj = 0; bj < 2; ++bj)
#pragma unroll
            for (int n = 0; n < 2; ++n) { const int col = col0 + bj * HALF + n * 16;
                const f32x4 sc = colscale ? *(const f32x4*)(colscale + col) : (f32x4){1.f, 1.f, 1.f, 1.f};
#pragma unroll
                for (int ai = 0; ai < 2; ++ai)
#pragma unroll
                    for (int m = 0; m < 4; ++m) *(f32x4*)(O + (size_t)(row0 + ai * HALF + m * 16) * ldc + col) = acc[ai][bj][m][n] * sc; }
    }
};

struct PanelSS {
    unsigned long long* gran;
    unsigned tag;
    template <class F>
    __device__ __forceinline__ void run(const float (&part)[2][4], const Unit& u, int wr, int wc, int fr, int fq, LAS unsigned char* lds, int wid, int lane, F&& emit) const {
        LAS float* P = (LAS float*)lds;
        LAS float* S = (LAS float*)(lds + 4096);
#pragma unroll
        for (int ai = 0; ai < 2; ++ai)
#pragma unroll
            for (int m = 0; m < 4; ++m) { float s = part[ai][m]; s = sum_xor32(sum_xor16(s));
                if (fq == 0) P[(ai * HALF + wr * 64 + m * 16 + fr) * 4 + wc] = s; }
        asm volatile("s_waitcnt lgkmcnt(0)" ::: "memory"); __builtin_amdgcn_s_barrier(); asm volatile("" ::: "memory");
        const int row = wid * 32 + (lane & 31);
        unsigned long long* g = gran + (size_t)(u.pm * BM + row) * 4;
        if (lane < 32) { const float t = (P[row * 4 + 0] + P[row * 4 + 1]) + (P[row * 4 + 2] + P[row * 4 + 3]);
            __hip_atomic_store(g + u.pn, ((unsigned long long)tag << 32) | (unsigned long long)__float_as_uint(t), __ATOMIC_RELAXED, __HIP_MEMORY_SCOPE_AGENT); }
        emit();
        float tot = 0.f;
        for (unsigned spins = 0;;) {
            bool ok = true; tot = 0.f;
            if (lane < 32) {
#pragma unroll
                for (int q = 0; q < 4; ++q) { const unsigned long long x = __hip_atomic_load(g + q, __ATOMIC_RELAXED, __HIP_MEMORY_SCOPE_AGENT); ok = ok && ((unsigned)(x >> 32) == tag); tot += __uint_as_float((unsigned)x); } }
            if (__all(ok)) break;
            if (++spins > (1u << 20)) break;
            __builtin_amdgcn_s_sleep(1);
        }
        if (lane < 32) S[row] = __builtin_amdgcn_rsqf(tot * (1.0f / 1024.0f) + 1e-6f);
        asm volatile("s_waitcnt lgkmcnt(0)" ::: "memory"); __builtin_amdgcn_s_barrier(); asm volatile("" ::: "memory");
    }
};
struct EpiFused {
    static constexpr bool PERM = true, AFTER_DRAIN = true;
    int l, stage; unsigned want;
    __device__ __forceinline__ void fused(f32x4 (&acc)[2][2][4][2], const Unit& u, int wr, int wc, int fr, int fq, LAS unsigned char* lds, int wid, int lane) const {
        const Params kp = kparams();
        const unsigned kf = want / 32u - 1u, rb = (kf >= 3u && kf <= 6u) ? 1u : 0u, wb = (kf >= 2u && kf <= 5u) ? 1u : 0u;
        const bf16_t* X16 = (const bf16_t*)(kp.ws + WS_X16 + rb * X16_COPY); bf16_t* X16w = (bf16_t*)(kp.ws + WS_X16 + wb * X16_COPY); const float* mod = (const float*)(kp.ws + WS_MOD);
        const float* colscale = (stage == 0 && (l & 1)) ? kp.pool_scale + (size_t)(l >> 1) * 1024 : nullptr;
        const int ln = stage == 0 ? l : (l < 3 ? l + 1 : 3);
        const float* modg = mod + (size_t)l * 5 * 6144; const int gate_idx = stage == 0 ? 2 : 5; const float* g_post = kp.norm_gains + (size_t)(l * 4 + (stage == 0 ? 1 : 3)) * 1024;
        const float* modh = mod + (size_t)ln * 5 * 6144; const int shift_idx = stage == 0 ? 3 : 0; const float* g_pre = kp.norm_gains + (size_t)(ln * 4 + (stage == 0 ? 2 : 0)) * 1024;
        const bool last = (stage == 1 && l == 3);
        const PanelSS st1{(unsigned long long*)(kp.ws + WS_XB1), 2u * kf + 1u}, st2{(unsigned long long*)(kp.ws + WS_XB2), 2u * kf + 2u};
        const LAS float* S = (const LAS float*)(lds + 4096);
        const int col0 = u.pn * BM + wc * 32 + 8 * fq, rowt = u.pm * BM;
        const int cond = rowt < 8192 ? 0 : 1 + ((rowt - 8192) >> 11);
        u32x4 pre[2][4][2];
#pragma unroll
        for (int m = 0; m < 4; ++m) { const bf16_t* xr = X16 + (size_t)(rowt + wr * 64 + m * 16 + fr) * 1024 + col0;
#pragma unroll
            for (int bj = 0; bj < 2; ++bj) pre[0][m][bj] = *(const u32x4*)(xr + bj * HALF); }
        if (colscale) {
#pragma unroll
            for (int bj = 0; bj < 2; ++bj)
#pragma unroll
                for (int n = 0; n < 2; ++n) { const f32x4 sc = *(const f32x4*)(colscale + col0 + bj * HALF + n * 4);
#pragma unroll
                    for (int ai = 0; ai < 2; ++ai)
#pragma unroll
                        for (int m = 0; m < 4; ++m) acc[ai][bj][m][n] *= sc; }
        }
        float part[2][4];
#pragma unroll
        for (int ai = 0; ai < 2; ++ai)
#pragma unroll
            for (int m = 0; m < 4; ++m) { float s = 0.f;
#pragma unroll
                for (int bj = 0; bj < 2; ++bj)
#pragma unroll
                    for (int n = 0; n < 2; ++n) { const f32x4 v = acc[ai][bj][m][n]; s += (v[0] * v[0] + v[1] * v[1]) + (v[2] * v[2] + v[3] * v[3]); }
                part[ai][m] = s; }
        f32x4 Gv[2][2];
        st1.run(part, u, wr, wc, fr, fq, lds, wid, lane, [&] {
#pragma unroll
            for (int m = 0; m < 2; ++m) { const bf16_t* xr = X16 + (size_t)(rowt + HALF + wr * 64 + m * 16 + fr) * 1024 + col0;
#pragma unroll
                for (int bj = 0; bj < 2; ++bj) pre[1][m][bj] = *(const u32x4*)(xr + bj * HALF); }
        });
#pragma unroll
        for (int m = 2; m < 4; ++m) { const bf16_t* xr = X16 + (size_t)(rowt + HALF + wr * 64 + m * 16 + fr) * 1024 + col0;
#pragma unroll
            for (int bj = 0; bj < 2; ++bj) pre[1][m][bj] = *(const u32x4*)(xr + bj * HALF); }
        {
#pragma unroll
            for (int bj = 0; bj < 2; ++bj)
#pragma unroll
                for (int n = 0; n < 2; ++n) { const int col = col0 + bj * HALF + n * 4;
                    Gv[bj][n] = *(const f32x4*)(modg + (size_t)cond * 6144 + gate_idx * 1024 + col) * *(const f32x4*)(g_post + col); }
#pragma unroll
            for (int ai = 0; ai < 2; ++ai)
#pragma unroll
                for (int m = 0; m < 4; ++m) { const float rs = S[ai * HALF + wr * 64 + m * 16 + fr];
#pragma unroll
                    for (int bj = 0; bj < 2; ++bj) { const u32x4 xp = pre[ai][m][bj];
                        const f32x4 xv0 = (f32x4){bf_lo(xp.x), bf_hi(xp.x), bf_lo(xp.y), bf_hi(xp.y)}, xv1 = (f32x4){bf_lo(xp.z), bf_hi(xp.z), bf_lo(xp.w), bf_hi(xp.w)};
                        acc[ai][bj][m][0] = xv0 + Gv[bj][0] * (acc[ai][bj][m][0] * rs); acc[ai][bj][m][1] = xv1 + Gv[bj][1] * (acc[ai][bj][m][1] * rs); } }
        }
        if (!last) {
#pragma unroll
            for (int ai = 0; ai < 2; ++ai)
#pragma unroll
                for (int m = 0; m < 4; ++m) { float s = 0.f;
#pragma unroll
                    for (int bj = 0; bj < 2; ++bj)
#pragma unroll
                        for (int n = 0; n < 2; ++n) { const f32x4 v = acc[ai][bj][m][n]; s += (v[0] * v[0] + v[1] * v[1]) + (v[2] * v[2] + v[3] * v[3]); }
                    part[ai][m] = s; }
            f32x4 Av[2][2], Bv[2][2];
            st2.run(part, u, wr, wc, fr, fq, lds, wid, lane, [&] {
#pragma unroll
                for (int bj = 0; bj < 2; ++bj)
#pragma unroll
                    for (int n = 0; n < 2; ++n) { const int col = col0 + bj * HALF + n * 4;
                        Av[bj][n] = *(const f32x4*)(g_pre + col) * (*(const f32x4*)(modh + (size_t)cond * 6144 + (shift_idx + 1) * 1024 + col) + 1.0f);
                        Bv[bj][n] = *(const f32x4*)(modh + (size_t)cond * 6144 + shift_idx * 1024 + col); }
#pragma unroll
                for (int ai = 0; ai < 2; ++ai)
#pragma unroll
                    for (int m = 0; m < 4; ++m) { const size_t off = (size_t)(rowt + ai * HALF + wr * 64 + m * 16 + fr) * 1024 + col0;
#pragma unroll
                        for (int bj = 0; bj < 2; ++bj) { const f32x4 x0 = acc[ai][bj][m][0], x1 = acc[ai][bj][m][1];
                            u32x4 xw; xw.x = cvt_pk_bf16(x0[0], x0[1]); xw.y = cvt_pk_bf16(x0[2], x0[3]); xw.z = cvt_pk_bf16(x1[0], x1[1]); xw.w = cvt_pk_bf16(x1[2], x1[3]);
                            *(u32x4*)(X16w + off + bj * HALF) = xw; } }
            });
            asm volatile("" : "+v"(fr), "+v"(fq));
            const int col0 = u.pn * BM + wc * 32 + 8 * fq;
            if (stage == 1 && (l & 1) == 0 && gridDim.x == 256) {
                if (u.pn == 0 && lane < 32) ((float*)(kp.ws + WS_RS))[rowt + wid * 32 + lane] = S[wid * 32 + lane];
                return;
            }
            bf16_t* H = (bf16_t*)(kp.ws + WS_H);
#pragma unroll
            for (int ai = 0; ai < 2; ++ai)
#pragma unroll
                for (int m = 0; m < 4; ++m) { const int r = ai * HALF + wr * 64 + m * 16 + fr; const float rs = S[r]; const size_t off = (size_t)(rowt + r) * 1024 + col0;
#pragma unroll
                    for (int bj = 0; bj < 2; ++bj) { const f32x4 x0 = acc[ai][bj][m][0], x1 = acc[ai][bj][m][1];
                        const f32x4 h0 = (x0 * rs) * Av[bj][0] + Bv[bj][0], h1 = (x1 * rs) * Av[bj][1] + Bv[bj][1];
                        u32x4 w; w.x = cvt_pk_bf16(h0[0], h0[1]); w.y = cvt_pk_bf16(h0[2], h0[3]); w.z = cvt_pk_bf16(h1[0], h1[1]); w.w = cvt_pk_bf16(h1[2], h1[3]);
                        *(u32x4*)(H + off + bj * HALF) = w; }
                    asm volatile("" ::: "memory"); }
        } else {
            float* X = kp.out;
#pragma unroll
            for (int ai = 0; ai < 2; ++ai)
#pragma unroll
                for (int m = 0; m < 4; ++m) { const size_t off = (size_t)(rowt + ai * HALF + wr * 64 + m * 16 + fr) * 1024 + col0;
#pragma unroll
                    for (int bj = 0; bj < 2; ++bj)
#pragma unroll
                        for (int n = 0; n < 2; ++n) *(f32x4*)(X + off + bj * HALF + n * 4) = acc[ai][bj][m][n]; }
        }
    }
};

template <class Epi, class Sched, bool ALIGN_EPI>
__device__ __forceinline__ void gemm_phase(LAS unsigned char* lds, const Gemm g, const Sched& S, const Epi& E) {
    const int tid = opaque_tid(), wid = __builtin_amdgcn_readfirstlane(tid >> 6), lane = tid & 63, wr = wid >> 2, wc = wid & 3, fr = lane & 15, fq = lane >> 4;
    const int K = g.K, nt = K / BK, lda = g.lda;
    unsigned voffA[2], voffB[2];
#pragma unroll
    for (int i = 0; i < 2; ++i) { int R, C; stage_rc(tid * 16 + i * 8192, R, C); const int Rb = Epi::PERM ? ((R & ~31) + perm32(R & 31)) : R;
        voffA[i] = (unsigned)(R * lda + C) * 2u; voffB[i] = (unsigned)(Rb * K + C) * 2u; }
    const size_t kstep = (size_t)(BK * 2);
    const size_t hA = (size_t)HALF * lda * 2, hB = (size_t)HALF * K * 2;
    const size_t tA = 2 * hA, tB = 2 * hB;
    const size_t acolB = (size_t)g.acol * 2;
    const unsigned ldsw = (unsigned)wid * 1024u;
    const int aoff = lds_byte(wr * 64 + fr, fq * 8), boff = lds_byte(wc * 32 + fr, fq * 8);
#define PG8_SA(b, h) (((b) * 2 + (h)) * HTB)
#define PG8_SB(b, h) ((4 + (b) * 2 + (h)) * HTB)
#define PG8_STAGE(bufoff, gbase, voff) do { _Pragma("unroll") for (int _i = 0; _i < 2; ++_i) \
        __builtin_amdgcn_global_load_lds((const unsigned*)((const char*)(gbase) + (voff)[_i]), (LAS unsigned*)(lds + (bufoff) + ldsw + _i * 8192), 16, 0, 0); } while (0)
#define PG8_LDA(dst, b, h) do { _Pragma("unroll") for (int m = 0; m < 4; ++m) _Pragma("unroll") for (int k = 0; k < 2; ++k) dst[m][k] = *(const LAS bf16x8*)(lds + PG8_SA(b, h) + aoff + m * 2048 + k * 1024); } while (0)
#define PG8_LDB(dst, b, h) do { _Pragma("unroll") for (int n = 0; n < 2; ++n) _Pragma("unroll") for (int k = 0; k < 2; ++k) dst[n][k] = *(const LAS bf16x8*)(lds + PG8_SB(b, h) + boff + n * 2048 + k * 1024); } while (0)
#define PG8_MMA(ai, bj, At, Bt) do { __builtin_amdgcn_s_setprio(1); _Pragma("unroll") for (int m = 0; m < 4; ++m) _Pragma("unroll") for (int n = 0; n < 2; ++n) _Pragma("unroll") for (int k = 0; k < 2; ++k) \
        acc[ai][bj][m][n] = __builtin_amdgcn_mfma_f32_16x16x32_bf16(Bt[n][k], At[m][k], acc[ai][bj][m][n], 0, 0, 0); __builtin_amdgcn_s_setprio(0); } while (0)
#define PG8_WAIT_V(n) asm volatile("s_waitcnt vmcnt(" #n ")" ::: "memory")
#define PG8_WAIT_L(n) asm volatile("s_waitcnt lgkmcnt(" #n ")" ::: "memory")
#define PG8_BAR __builtin_amdgcn_s_barrier()
#define PG8_SCHED __builtin_amdgcn_sched_barrier(0)
    Unit cur, nxt; int ui = 0;
    if (!S.next(0, cur)) return;
    f32x4 acc[2][2][4][2];
#pragma unroll
    for (int a = 0; a < 2; ++a)
#pragma unroll
        for (int b = 0; b < 2; ++b)
#pragma unroll
            for (int m = 0; m < 4; ++m)
#pragma unroll
                for (int n = 0; n < 2; ++n) acc[a][b][m][n] = (f32x4){0.f, 0.f, 0.f, 0.f};
    bf16x8 At[4][2], B0[2][2], B1[2][2];
    const char* cA = (const char*)g.A + (size_t)cur.pm * tA + (size_t)cur.pn * acolB; const char* cB = (const char*)g.Bt + (size_t)cur.pn * tB;
    PG8_STAGE(PG8_SB(0, 0), cB, voffB); PG8_STAGE(PG8_SB(0, 1), cB + hB, voffB); PG8_STAGE(PG8_SA(0, 0), cA, voffA); PG8_STAGE(PG8_SA(0, 1), cA + hA, voffA);
    if (wr == 1) PG8_BAR;
    PG8_WAIT_V(2); PG8_BAR;
    PG8_STAGE(PG8_SB(1, 0), cB + kstep, voffB); PG8_STAGE(PG8_SA(1, 0), cA + kstep, voffA); PG8_STAGE(PG8_SB(1, 1), cB + hB + kstep, voffB);
    PG8_WAIT_V(6); PG8_BAR;
    for (;;) {
        const bool has_next = S.next(ui + 1, nxt);
        const char* nA = has_next ? (const char*)g.A + (size_t)nxt.pm * tA + (size_t)nxt.pn * acolB : cA; const char* nB = has_next ? (const char*)g.Bt + (size_t)nxt.pn * tB : cB;
        for (int t = 0; t < nt; t += 2) {
            const bool last = (t == nt - 2);
            const char* a1 = cA + (size_t)(t + 1) * kstep;
            const char* a2 = last ? nA : cA + (size_t)(t + 2) * kstep; const char* b2 = last ? nB : cB + (size_t)(t + 2) * kstep;
            const char* a3 = a2 + kstep; const char* b3 = b2 + kstep;
            PG8_LDB(B0, 0, 0); PG8_LDB(B1, 0, 1); PG8_SCHED; PG8_LDA(At, 0, 0); PG8_STAGE(PG8_SA(1, 1), a1 + hA, voffA);
            PG8_WAIT_V(8); PG8_WAIT_L(0); PG8_BAR; PG8_MMA(0, 0, At, B0); PG8_MMA(0, 1, At, B1); PG8_BAR; PG8_SCHED;
            PG8_LDA(At, 0, 1); PG8_STAGE(PG8_SB(0, 0), b2, voffB); PG8_STAGE(PG8_SB(0, 1), b2 + hB, voffB); PG8_STAGE(PG8_SA(0, 0), a2, voffA);
            PG8_WAIT_V(8); PG8_WAIT_L(0); PG8_BAR; PG8_MMA(1, 0, At, B0); PG8_MMA(1, 1, At, B1); PG8_BAR; PG8_SCHED;
            PG8_LDB(B0, 1, 0); PG8_LDB(B1, 1, 1); PG8_SCHED; PG8_LDA(At, 1, 0); PG8_STAGE(PG8_SA(0, 1), a2 + hA, voffA);
            PG8_WAIT_V(8); PG8_WAIT_L(0); PG8_BAR; PG8_MMA(0, 0, At, B0); PG8_MMA(0, 1, At, B1); PG8_BAR; PG8_SCHED;
            PG8_LDA(At, 1, 1); PG8_STAGE(PG8_SB(1, 0), b3, voffB); PG8_STAGE(PG8_SB(1, 1), b3 + hB, voffB); PG8_STAGE(PG8_SA(1, 0), a3, voffA);
            PG8_WAIT_V(8); PG8_WAIT_L(0); PG8_BAR; PG8_MMA(1, 0, At, B0); PG8_MMA(1, 1, At, B1); PG8_BAR; PG8_SCHED;
        }
        if constexpr (ALIGN_EPI) { if (wr == 0) PG8_BAR; }
        if constexpr (!Epi::AFTER_DRAIN) { int fr_ = fr, fq_ = fq, wr_ = wr, wc_ = wc; asm volatile("" : "+v"(fr_), "+v"(fq_), "+s"(wr_), "+s"(wc_)); E(acc, cur, wr_, wc_, fr_, fq_, lds); }
        if (!has_next) break;
#pragma unroll
        for (int a = 0; a < 2; ++a)
#pragma unroll
            for (int b = 0; b < 2; ++b)
#pragma unroll
                for (int m = 0; m < 4; ++m)
#pragma unroll
                    for (int n = 0; n < 2; ++n) acc[a][b][m][n] = (f32x4){0.f, 0.f, 0.f, 0.f};
        cur = nxt; cA = nA; cB = nB; ++ui;
        if constexpr (ALIGN_EPI) { if (wr == 1) PG8_BAR; }
    }
    PG8_WAIT_V(0);
    if constexpr (!ALIGN_EPI) { if (wr == 0) PG8_BAR; }
    PG8_BAR;
    if constexpr (Epi::AFTER_DRAIN) { int fr_ = fr, fq_ = fq, wr_ = wr, wc_ = wc; asm volatile("" : "+v"(fr_), "+v"(fq_), "+s"(wr_), "+s"(wc_)); E.fused(acc, cur, wr_, wc_, fr_, fq_, lds, wid, lane); }
#undef PG8_SA
#undef PG8_SB
#undef PG8_STAGE
#undef PG8_LDA
#undef PG8_LDB
#undef PG8_MMA
#undef PG8_WAIT_V
#undef PG8_WAIT_L
#undef PG8_BAR
#undef PG8_SCHED
}
}

namespace attn {
constexpr int D = 128, NW = 8, QBLK = 32, KVBLK = 64;
constexpr float SCALE = 0.088388347648318440f;
constexpr float THR = 8.f;
constexpr int LDQ = DM, LDK = KVW, LDO = DM;
constexpr size_t SHM_V = KVBLK * D * 2, SHM_K = KVBLK * D * 2, SHM_ATTN = 2 * SHM_V + 2 * SHM_K + NW * 64 * 4;
#define KSWZ(row, colB) ((row) * 256 + ((colB) ^ (((row) & 7) << 4)))
#define SBAR() __builtin_amdgcn_sched_barrier(0)
__device__ __forceinline__ int crow(int r, int hi) { return (r & 3) + 8 * (r >> 2) + 4 * hi; }
__device__ __forceinline__ unsigned cvtpk(float lo, float hi) { unsigned r; asm volatile("v_cvt_pk_bf16_f32 %0, %1, %2" : "=v"(r) : "v"(lo), "v"(hi)); return r; }
__device__ __forceinline__ void partialSM(f32x16& p0, f32x16& p1, float& m_reg, float& mn, float& alpha) {
  constexpr float C = SCALE * 1.4426950408889634f;
  float pmax = p0[0]; for (int r = 1; r < 16; ++r) pmax = fmaxf(pmax, p0[r]); for (int r = 0; r < 16; ++r) pmax = fmaxf(pmax, p1[r]);
  { auto rr = __builtin_amdgcn_permlane32_swap(__float_as_uint(pmax), __float_as_uint(pmax), false, false);
    pmax = fmaxf(__uint_as_float(rr[0]), __uint_as_float(rr[1])); }
  if (__builtin_expect(__all(pmax - m_reg <= THR / SCALE), 1)) { mn = m_reg; alpha = 1.f; }
  else { mn = fmaxf(m_reg, pmax); alpha = __builtin_amdgcn_exp2f((m_reg - mn) * C); m_reg = mn; }
  float mnC = -mn * C;
  for (int r = 0; r < 16; ++r) p0[r] = fmaf(p0[r], C, mnC); for (int r = 0; r < 16; ++r) p1[r] = fmaf(p1[r], C, mnC);
  for (int r = 0; r < 16; ++r) p0[r] = __builtin_amdgcn_exp2f(p0[r]);
}
__device__ __forceinline__ void finishSM(f32x16& p0, f32x16& p1, float alpha, float& l_reg, bf16x8& pa0, bf16x8& pa1, bf16x8& pa2, bf16x8& pa3) {
  for (int r = 0; r < 16; ++r) p1[r] = __builtin_amdgcn_exp2f(p1[r]);
  float ps = 0; for (int r = 0; r < 16; ++r) ps += p0[r]; for (int r = 0; r < 16; ++r) ps += p1[r];
  { auto rr = __builtin_amdgcn_permlane32_swap(__float_as_uint(ps), __float_as_uint(ps), false, false);
    ps = __uint_as_float(rr[0]) + __uint_as_float(rr[1]); }
  l_reg = l_reg * alpha + ps;
#define PK4(P, BASE, OUT) do { unsigned a0 = cvtpk(P[BASE + 0], P[BASE + 1]), a1 = cvtpk(P[BASE + 2], P[BASE + 3]);   \
    unsigned b0 = cvtpk(P[BASE + 4], P[BASE + 5]), b1 = cvtpk(P[BASE + 6], P[BASE + 7]);                              \
    auto r0 = __builtin_amdgcn_permlane32_swap(a0, b0, false, false); auto r1 = __builtin_amdgcn_permlane32_swap(a1, b1, false, false); \
    u32x4 w = {r0[0], r1[0], r0[1], r1[1]}; OUT = *reinterpret_cast<bf16x8*>(&w); } while (0)
  PK4(p0, 0, pa0); PK4(p0, 8, pa1); PK4(p1, 0, pa2); PK4(p1, 8, pa3);
#undef PK4
}
__device__ __forceinline__ void qkt(f32x16& p0, f32x16& p1, const bf16_t* Ks, const bf16x8* qr, int r32, int hi) {
  p0 = f32x16{}; p1 = f32x16{};
#pragma unroll
  for (int d0 = 0; d0 < 8; ++d0) { int cb = (d0 * 16 + hi * 8) * 2;
    bf16x8 b0 = *reinterpret_cast<const bf16x8*>((const char*)Ks + KSWZ(r32, cb));
    bf16x8 b1 = *reinterpret_cast<const bf16x8*>((const char*)Ks + KSWZ(32 + r32, cb));
    p0 = __builtin_amdgcn_mfma_f32_32x32x16_bf16(b0, qr[d0], p0, 0, 0, 0);
    p1 = __builtin_amdgcn_mfma_f32_32x32x16_bf16(b1, qr[d0], p1, 0, 0, 0); }
}
__device__ __forceinline__ int v_st(int k, int c) { const int kk = (k & ~0xC) | ((k & 4) << 1) | ((k & 8) >> 1); return ((kk >> 3) * 4 + (c >> 5)) * 512 + ((kk & 7) * 32 + (c & 31)) * 2; }
__device__ __forceinline__ int v_rd_base(int lane) { return ((lane & 3) << 3) | (((lane >> 2) & 3) << 6) | (((lane >> 4) & 1) << 5) | (((lane >> 5) & 1) << 8); }
constexpr int v_rd_off(int d0, int ks, int half) { return d0 * 512 + ks * 4096 + half * 2048; }
template <int OFF> __device__ __forceinline__ s16x4 tr_read(int vb) {
  s16x4 r; asm volatile("ds_read_b64_tr_b16 %0, %1 offset:%2" : "=&v"(r) : "v"(vb), "i"(OFF) : "memory"); return r;
}
template <int D0> __device__ __forceinline__ void pv_one(f32x16& od, int vb, bf16x8 pa0, bf16x8 pa1, bf16x8 pa2, bf16x8 pa3) {
  const s16x4 l0 = tr_read<v_rd_off(D0, 0, 0)>(vb), h0 = tr_read<v_rd_off(D0, 0, 1)>(vb), l1 = tr_read<v_rd_off(D0, 1, 0)>(vb), h1 = tr_read<v_rd_off(D0, 1, 1)>(vb);
  const s16x4 l2 = tr_read<v_rd_off(D0, 2, 0)>(vb), h2 = tr_read<v_rd_off(D0, 2, 1)>(vb), l3 = tr_read<v_rd_off(D0, 3, 0)>(vb), h3 = tr_read<v_rd_off(D0, 3, 1)>(vb);
  asm volatile("s_waitcnt lgkmcnt(0)" ::: "memory"); SBAR();
#define PK(L, H) (bf16x8){L[0], L[1], L[2], L[3], H[0], H[1], H[2], H[3]}
  od = __builtin_amdgcn_mfma_f32_32x32x16_bf16(pa0, PK(l0, h0), od, 0, 0, 0);
  od = __builtin_amdgcn_mfma_f32_32x32x16_bf16(pa1, PK(l1, h1), od, 0, 0, 0);
  od = __builtin_amdgcn_mfma_f32_32x32x16_bf16(pa2, PK(l2, h2), od, 0, 0, 0);
  od = __builtin_amdgcn_mfma_f32_32x32x16_bf16(pa3, PK(l3, h3), od, 0, 0, 0);
#undef PK
}
__device__ __forceinline__ void pv_d0(f32x16* o, int vb, bf16x8 pa0, bf16x8 pa1, bf16x8 pa2, bf16x8 pa3) {
  pv_one<0>(o[0], vb, pa0, pa1, pa2, pa3); pv_one<1>(o[1], vb, pa0, pa1, pa2, pa3); pv_one<2>(o[2], vb, pa0, pa1, pa2, pa3); pv_one<3>(o[3], vb, pa0, pa1, pa2, pa3);
}
__device__ __forceinline__ void attn_dense_body(const bf16_t* __restrict__ Qb, const bf16_t* __restrict__ Kh, const bf16_t* __restrict__ Vh,
                                                bf16_t* __restrict__ Ob, int seq, char* lds) {
  const int tid = opaque_tid(), wid = tid >> 6, lane = tid & 63, r32 = lane & 31, hi = lane >> 5;
  bf16_t* V_lds = (bf16_t*)lds; bf16_t* K_lds = (bf16_t*)(lds + 2 * SHM_V);
  float* ws = (float*)(lds + 2 * SHM_V + 2 * SHM_K) + wid * 64; float* li_l = ws; float* al_l = ws + 32;
  float m_reg = -1e30f, l_reg = 0; f32x16 o[4] = {}; bf16x8 qr[8];
  const bf16_t* Qw = Qb + (long)(wid * QBLK + r32) * LDQ + hi * 8;
#pragma unroll
  for (int d0 = 0; d0 < 8; ++d0) qr[d0] = *reinterpret_cast<const bf16x8*>(Qw + d0 * 16);
  const int sr = tid >> 4, sc = (tid & 15) * 8, vst0 = v_st(sr, sc), vst1 = v_st(32 + sr, sc);
  const int vb0 = (int)(uintptr_t)V_lds + v_rd_base(lane);
  struct { bf16x8 vs0, vs1, ks0, ks1; } sr_[2];
#define SLOAD(i, k0) do { sr_[i].vs0 = *reinterpret_cast<const bf16x8*>(&Vh[(long)((k0) + sr) * LDK + sc]); sr_[i].vs1 = *reinterpret_cast<const bf16x8*>(&Vh[(long)((k0) + 32 + sr) * LDK + sc]); \
    sr_[i].ks0 = *reinterpret_cast<const bf16x8*>(&Kh[(long)((k0) + sr) * LDK + sc]); sr_[i].ks1 = *reinterpret_cast<const bf16x8*>(&Kh[(long)((k0) + 32 + sr) * LDK + sc]); } while (0)
#define SWRITE(b, i) do { *(bf16x8*)((char*)V_lds + (b) * SHM_V + vst0) = sr_[i].vs0;          \
    *(bf16x8*)((char*)V_lds + (b) * SHM_V + vst1) = sr_[i].vs1; int kc = sc * 2;               \
    *(bf16x8*)((char*)K_lds + (b) * SHM_K + KSWZ(sr, kc)) = sr_[i].ks0;                       \
    *(bf16x8*)((char*)K_lds + (b) * SHM_K + KSWZ(32 + sr, kc)) = sr_[i].ks1; } while (0)
#define SWAIT() asm volatile("s_waitcnt vmcnt(4)" ::: "memory")
#define RESC(a) do { if (__any((a) < 1.f)) { if (hi == 0) al_l[r32] = (a); asm volatile("s_waitcnt lgkmcnt(0)" ::: "memory"); \
    for (int d = 0; d < 4; ++d) for (int r = 0; r < 16; ++r) o[d][r] *= al_l[crow(r, hi)]; } } while (0)
  f32x16 pA0, pA1, pB0, pB1; float mnA, mnB, alA, alB; bf16x8 pa0, pa1, pa2, pa3; const int NT = seq / KVBLK;
  constexpr int SE = 0, SO = 1;
  SLOAD(SE, 0); asm volatile("s_waitcnt vmcnt(0)" ::: "memory"); SWRITE(0, SE); __syncthreads();
  qkt(pA0, pA1, K_lds, qr, r32, hi); partialSM(pA0, pA1, m_reg, mnA, alA);
  SLOAD(SO, KVBLK); if (2 < NT) SLOAD(SE, 2 * KVBLK);
  SWAIT(); SWRITE(1, SO); __syncthreads();
  for (int j = 1; j + 1 < NT; j += 2) {
    SBAR(); qkt(pB0, pB1, (bf16_t*)((char*)K_lds + SHM_K), qr, r32, hi);
    finishSM(pA0, pA1, alA, l_reg, pa0, pa1, pa2, pa3); SBAR();
    SLOAD(SO, (j + 2) * KVBLK); SBAR();
    pv_d0(o, vb0, pa0, pa1, pa2, pa3); partialSM(pB0, pB1, m_reg, mnB, alB);
    __syncthreads(); SWAIT(); SWRITE(0, SE);
    RESC(alB); __syncthreads();
    SBAR(); qkt(pA0, pA1, K_lds, qr, r32, hi);
    finishSM(pB0, pB1, alB, l_reg, pa0, pa1, pa2, pa3); SBAR();
    if (j + 3 < NT) SLOAD(SE, (j + 3) * KVBLK); SBAR();
    pv_d0(o, vb0 + (int)SHM_V, pa0, pa1, pa2, pa3); partialSM(pA0, pA1, m_reg, mnA, alA);
    __syncthreads(); SWAIT(); SWRITE(1, SO);
    RESC(alA); __syncthreads();
  }
  SBAR(); qkt(pB0, pB1, (bf16_t*)((char*)K_lds + SHM_K), qr, r32, hi);
  finishSM(pA0, pA1, alA, l_reg, pa0, pa1, pa2, pa3); SBAR();
  pv_d0(o, vb0, pa0, pa1, pa2, pa3); partialSM(pB0, pB1, m_reg, mnB, alB);
  __syncthreads(); RESC(alB);
  finishSM(pB0, pB1, alB, l_reg, pa0, pa1, pa2, pa3); SBAR();
  pv_d0(o, vb0 + (int)SHM_V, pa0, pa1, pa2, pa3);
  if (hi == 0) li_l[r32] = l_reg; asm volatile("s_waitcnt lgkmcnt(0)" ::: "memory");
  float rli[16];
#pragma unroll
  for (int r = 0; r < 16; ++r) rli[r] = __builtin_amdgcn_rcpf(li_l[crow(r, hi)]);
  bf16_t* Ow = Ob + (long)(wid * QBLK) * LDO;
#pragma unroll
  for (int r = 0; r < 16; ++r) { int orow = crow(r, hi);
#pragma unroll
    for (int d0 = 0; d0 < 4; ++d0) { const float v = o[d0][r] * rli[r]; Ow[(long)orow * LDO + d0 * 32 + r32] = (bf16_t)(cvtpk(v, v) & 0xffffu); } }
#undef SLOAD
#undef SWRITE
#undef SWAIT
#undef RESC
}
}

__device__ __forceinline__ int up_row(int n) { const int n2 = n >= DFF ? n - DFF : n; return 8 * (n2 >> 2) + (n2 & 3) + (n >= DFF ? 4 : 0); }
__device__ __forceinline__ int qkv_row(int n) { const int d = n & 127, a = d >> 6, nn = (d >> 5) & 1, pp = d & 31; return (n & ~127) + 8 * ((32 * a + pp) >> 2) + 4 * nn + (pp & 3); }
__device__ __forceinline__ void transpose_item(const float* W, int K, int N, bf16_t* WT, int rmap, LAS float* scr, int item, int lane) {
    const int nblk = N / 32, kb = item / nblk, nb = item % nblk, k0 = 64 * kb, n0 = 32 * nb;
    float tv[32];
    const float* wp = W + (size_t)(k0 + (lane >> 5)) * N + n0 + (lane & 31);
#pragma unroll
    for (int i = 0; i < 32; ++i) tv[i] = wp[(size_t)(2 * i) * N];
#pragma unroll
    for (int i = 0; i < 32; ++i) scr[(2 * i + (lane >> 5)) * 33 + (lane & 31)] = tv[i];
    asm volatile("s_waitcnt lgkmcnt(0)" ::: "memory");
    const int c = lane & 7;
#pragma unroll
    for (int j = 0; j < 4; ++j) { const int n = (lane >> 3) + 8 * j; const LAS float* s = scr + (8 * c) * 33 + n;
        u32x4 o; o.x = cvt_pk_bf16(s[0 * 33], s[1 * 33]); o.y = cvt_pk_bf16(s[2 * 33], s[3 * 33]); o.z = cvt_pk_bf16(s[4 * 33], s[5 * 33]); o.w = cvt_pk_bf16(s[6 * 33], s[7 * 33]);
        const int dr = rmap == 1 ? up_row(n0 + n) : (rmap == 2 ? qkv_row(n0 + n) : (n0 + n));
        *(u32x4*)(WT + (size_t)dr * K + k0 + 8 * c) = o; }
    asm volatile("s_waitcnt lgkmcnt(0)" ::: "memory");
}

__device__ __forceinline__ void convert_layer_weights(int l, int widx, int nw, LAS unsigned char* lds) {
    const Params p = kparams(); unsigned char* ws = p.ws;
    const int tid = opaque_tid(), lane = tid & 63, wave = __builtin_amdgcn_readfirstlane(tid >> 6);
    LAS float* scr = (LAS float*)(lds + 65536 + wave * 8704);
    constexpr int I_QKV = 16 * 48, I_O = 16 * 32, I_PL = 4 * 8, I_UP = 16 * 176, I_DN = 44 * 32;
    const int nmix = (l & 1) ? 4 * I_PL : I_QKV + I_O, nitems = I_UP + I_DN + nmix, a = l >> 1;
    for (int it = widx; it < nitems; it += nw) {
        int r = it; const float* W; bf16_t* WT; int K, N, sub; int upm = 0;
        if (r < I_UP) { sub = r; W = p.w_up + (size_t)l * DM * 2 * DFF; K = DM; N = 2 * DFF; WT = (bf16_t*)(ws + WS_WUP) + (size_t)l * 2 * DFF * DM; upm = 1; }
        else if ((r -= I_UP) < I_DN) { sub = r; W = p.w_down + (size_t)l * DFF * DM; K = DFF; N = DM; WT = (bf16_t*)(ws + WS_WDN) + (size_t)l * DM * DFF; }
        else if (l & 1) { r -= I_DN; const int pg = a * 4 + r / I_PL; sub = r % I_PL; W = p.w_pool + (size_t)pg * 65536; K = 256; N = 256; WT = (bf16_t*)(ws + WS_WPOOL) + (size_t)pg * 65536; }
        else if ((r -= I_DN) < I_QKV) { sub = r; W = p.w_qkv + (size_t)a * DM * QKVW; K = DM; N = QKVW; WT = (bf16_t*)(ws + WS_WQKV) + (size_t)a * QKVW * DM; upm = 2; }
        else { sub = r - I_QKV; W = p.w_o + (size_t)a * DM * DM; K = DM; N = DM; WT = (bf16_t*)(ws + WS_WO) + (size_t)a * DM * DM; }
        transpose_item(W, K, N, WT, upm, scr, sub, lane);
    }
}

__device__ __forceinline__ void mod_items(int item_begin, int item_end, int bidx, int nblk, LAS unsigned char* lds) {
    const Params p = kparams();
    const int tid = opaque_tid();
    LAS float* sil = (LAS float*)lds;
    LAS float* red = (LAS float*)(lds + 20480);
    if (item_begin + bidx >= item_end) return;
    for (int i = tid; i < 5 * DM; i += 512) { const int cnd = i >> 10, k = i & 1023; const float v = cnd == 0 ? p.c_ctx[k] : p.c[(cnd - 1) * DM + k]; sil[i] = silu_f(v); }
    __syncthreads();
    float* modo = (float*)(p.ws + WS_MOD);
    for (int item = item_begin + bidx; item < item_end; item += nblk) {
        const int l = item / 192, col0 = (item % 192) * 32, cgp = tid & 7, kr = tid >> 3;
        f32x4 acc[5];
#pragma unroll
        for (int cnd = 0; cnd < 5; ++cnd) acc[cnd] = (f32x4){0.f, 0.f, 0.f, 0.f};
        const float* wp = p.w_ada + ((size_t)l * DM + kr) * NMODW + col0 + 4 * cgp;
        f32x4 w4[16];
#pragma unroll
        for (int i = 0; i < 16; ++i) w4[i] = *(const f32x4*)(wp + (size_t)i * 64 * NMODW);
#pragma unroll
        for (int i = 0; i < 16; ++i) { const int k = kr + 64 * i;
#pragma unroll
            for (int cnd = 0; cnd < 5; ++cnd) acc[cnd] += w4[i] * sil[cnd * DM + k]; }
#pragma unroll
        for (int cnd = 0; cnd < 5; ++cnd) *(LAS f32x4*)(red + (kr * 5 + cnd) * 32 + 4 * cgp) = acc[cnd];
        __syncthreads();
        if (tid < 160) { const int cnd = tid >> 5, col = tid & 31; float s = 0.f;
#pragma unroll 8
            for (int k2 = 0; k2 < 64; ++k2) s += red[(k2 * 5 + cnd) * 32 + col];
            modo[(size_t)(l * 5 + cnd) * NMODW + col0 + col] = s + p.b_ada[l * NMODW + col0 + col]; }
        __syncthreads();
    }
}

__device__ __forceinline__ void prep_phase(LAS unsigned char* lds) {
    const Params p = kparams();
    const int tid = opaque_tid(), lane = tid & 63, wave = __builtin_amdgcn_readfirstlane(tid >> 6), G = gridDim.x, gw = blockIdx.x * NWAVES + wave, NGW = G * NWAVES; (void)tid; (void)lane; (void)wave; (void)gw; (void)NGW; (void)G;
    unsigned char* ws = p.ws;
    convert_layer_weights(0, gw, NGW, lds);
    for (int it = gw; it < 2 * 4 * PAST; it += NGW) {
        const int alx = it >> 11, idx = it & 2047, b = idx >> 9, pp = idx & (PAST - 1);
        const size_t srco = ((size_t)(b * 2 + alx) * PAST + pp) * KVW + lane * 4, dst = ((size_t)b * KV_S + SEQ_S + pp) * KVW + lane * 4;
        const f32x4 kv = *(const f32x4*)(p.cache_k + srco), vv = *(const f32x4*)(p.cache_v + srco);
        u32x2 wk, wv; wk.x = cvt_pk_bf16(kv[0], kv[1]); wk.y = cvt_pk_bf16(kv[2], kv[3]); wv.x = cvt_pk_bf16(vv[0], vv[1]); wv.y = cvt_pk_bf16(vv[2], vv[3]);
        *(u32x2*)((bf16_t*)(ws + WS_KS + (size_t)alx * KVS_LAYER) + dst) = wk; *(u32x2*)((bf16_t*)(ws + WS_VS + (size_t)alx * KVS_LAYER) + dst) = wv;
    }
}

__device__ __forceinline__ void rowpass(const float* xsrc_p, const float* xsrc_s, float* xdst, const float* yraw,
                                        const float* modg, int gate_idx, const float* g_post, const float* modh, int shift_idx, const float* g_pre, bf16_t* H, bf16_t* X16) {
    const int tid = opaque_tid(), lane = tid & 63, wave = __builtin_amdgcn_readfirstlane(tid >> 6), G = gridDim.x, gw = blockIdx.x * NWAVES + wave, NGW = G * NWAVES; (void)tid; (void)lane; (void)wave; (void)gw; (void)NGW; (void)G;
    for (int r0 = gw * 8; r0 < NTOK; r0 += NGW * 8) {
        const int cond = r0 < NP ? 0 : 1 + ((r0 - NP) >> 11);
        f32x4 Gv[4], Av[4], Bv[4];
#pragma unroll
        for (int j = 0; j < 4; ++j) { const int col = 4 * lane + 256 * j;
            Gv[j] = (f32x4){0.f, 0.f, 0.f, 0.f}; Av[j] = Gv[j]; Bv[j] = Gv[j];
            if (yraw) Gv[j] = *(const f32x4*)(modg + (size_t)cond * NMODW + gate_idx * DM + col) * *(const f32x4*)(g_post + col);
            if (H) { const f32x4 sh = *(const f32x4*)(modh + (size_t)cond * NMODW + shift_idx * DM + col), scl = *(const f32x4*)(modh + (size_t)cond * NMODW + (shift_idx + 1) * DM + col);
                Av[j] = *(const f32x4*)(g_pre + col) * (scl + 1.0f); Bv[j] = sh; } }
#pragma unroll 4
        for (int i = 0; i < 8; ++i) { const int row = r0 + i;
            const float* xr = row < NP ? xsrc_p + (size_t)row * DM : xsrc_s + (size_t)(row - NP) * DM;
            f32x4 v[4];
#pragma unroll
            for (int j = 0; j < 4; ++j) v[j] = *(const f32x4*)(xr + 4 * lane + 256 * j);
            if (yraw) { f32x4 y[4]; float ss = 0.f;
#pragma unroll
                for (int j = 0; j < 4; ++j) { y[j] = *(const f32x4*)(yraw + (size_t)row * DM + 4 * lane + 256 * j); ss += (y[j][0] * y[j][0] + y[j][1] * y[j][1]) + (y[j][2] * y[j][2] + y[j][3] * y[j][3]); }
                const float rs = 1.0f / sqrtf(wave_sum(ss) * (1.0f / DM) + EPS);
#pragma unroll
                for (int j = 0; j < 4; ++j) v[j] += Gv[j] * (y[j] * rs); }
            if (xdst) {
#pragma unroll
                for (int j = 0; j < 4; ++j) *(f32x4*)(xdst + (size_t)row * DM + 4 * lane + 256 * j) = v[j]; }
            if (X16) {
#pragma unroll
                for (int j = 0; j < 4; ++j) { u32x2 w; w.x = cvt_pk_bf16(v[j][0], v[j][1]); w.y = cvt_pk_bf16(v[j][2], v[j][3]); *(u32x2*)(X16 + (size_t)row * DM + 4 * lane + 256 * j) = w; } }
            if (H) { float ss = 0.f;
#pragma unroll
                for (int j = 0; j < 4; ++j) ss += (v[j][0] * v[j][0] + v[j][1] * v[j][1]) + (v[j][2] * v[j][2] + v[j][3] * v[j][3]);
                const float rs = 1.0f / sqrtf(wave_sum(ss) * (1.0f / DM) + EPS);
#pragma unroll
                for (int j = 0; j < 4; ++j) { const f32x4 h = (v[j] * rs) * Av[j] + Bv[j]; u32x2 w; w.x = cvt_pk_bf16(h[0], h[1]); w.y = cvt_pk_bf16(h[2], h[3]);
                    *(u32x2*)(H + (size_t)row * DM + 4 * lane + 256 * j) = w; } }
        }
    }
}

template <int GI> __device__ __forceinline__ void pool_item(const bf16_t* H, bf16_t* P, int chunk, int lane) {
    constexpr int half = 1 << GI, NR = 31 + 2 * half;
    const int t0 = chunk * 32;
    int ss, T; if (t0 < NP) { ss = t0 & ~(SEQ_P - 1); T = SEQ_P; } else { ss = NP + ((t0 - NP) & ~(SEQ_S - 1)); T = SEQ_S; }
    const int tl0 = t0 - ss;
    const bf16_t* base = H + (size_t)ss * DM + GI * 256 + lane * 4;
    u32x2 v[NR];
#pragma unroll
    for (int i = 0; i < NR; ++i) { const int rl = tl0 - half + i; const bool ok = (rl >= 0) && (rl < T); const u32x2 x = *(const u32x2*)(base + (size_t)(ok ? rl : tl0) * DM); v[i].x = ok ? x.x : 0u; v[i].y = ok ? x.y : 0u; }
    f32x4 S = (f32x4){0.f, 0.f, 0.f, 0.f};
#pragma unroll
    for (int i = 0; i < 2 * half; ++i) { S[0] += bf_lo(v[i].x); S[1] += bf_hi(v[i].x); S[2] += bf_lo(v[i].y); S[3] += bf_hi(v[i].y); }
    bf16_t* out = P + (size_t)t0 * DM + GI * 256 + lane * 4;
#pragma unroll
    for (int j = 0; j < 32; ++j) { const int tl = tl0 + j; const int lo = tl - half < 0 ? 0 : tl - half, hi = tl + half > T ? T : tl + half; const float inv = 1.0f / (float)(hi - lo);
        const u32x2 c = v[j + half]; u32x2 w; w.x = cvt_pk_bf16(S[0] * inv - bf_lo(c.x), S[1] * inv - bf_hi(c.x)); w.y = cvt_pk_bf16(S[2] * inv - bf_lo(c.y), S[3] * inv - bf_hi(c.y));
        *(u32x2*)(out + (size_t)j * DM) = w;
        if (j < 31) { const u32x2 a = v[j + 2 * half], d = v[j]; S[0] += bf_lo(a.x) - bf_lo(d.x); S[1] += bf_hi(a.x) - bf_hi(d.x); S[2] += bf_lo(a.y) - bf_lo(d.y); S[3] += bf_hi(a.y) - bf_hi(d.y); } }
}
template <int GI> __device__ __forceinline__ void pool_item_x(const bf16_t* X16, const float* RS, f32x4 Av, bf16_t* P, int chunk, int lane) {
    constexpr int half = 1 << GI, NR = 31 + 2 * half;
    const int t0 = chunk * 32;
    int ss, T; if (t0 < NP) { ss = t0 & ~(SEQ_P - 1); T = SEQ_P; } else { ss = NP + ((t0 - NP) & ~(SEQ_S - 1)); T = SEQ_S; }
    const int tl0 = t0 - ss;
    const bf16_t* base = X16 + (size_t)ss * DM + GI * 256 + lane * 4;
    u32x2 v[NR]; float rv[NR];
#pragma unroll
    for (int i = 0; i < NR; ++i) { const int rl = tl0 - half + i; const bool ok = (rl >= 0) && (rl < T); const int rc = ok ? rl : tl0;
        const u32x2 x = *(const u32x2*)(base + (size_t)rc * DM); v[i].x = ok ? x.x : 0u; v[i].y = ok ? x.y : 0u; rv[i] = RS[ss + rc]; }
#define XH(i) ((f32x4){bf_lo(v[i].x), bf_hi(v[i].x), bf_lo(v[i].y), bf_hi(v[i].y)} * rv[i])
    f32x4 S = (f32x4){0.f, 0.f, 0.f, 0.f};
#pragma unroll
    for (int i = 0; i < 2 * half; ++i) S += XH(i);
    bf16_t* out = P + (size_t)t0 * DM + GI * 256 + lane * 4;
#pragma unroll
    for (int j = 0; j < 32; ++j) { const int tl = tl0 + j; const int lo = tl - half < 0 ? 0 : tl - half, hi = tl + half > T ? T : tl + half; const float inv = 1.0f / (float)(hi - lo);
        const f32x4 o = Av * (S * inv - XH(j + half)); u32x2 w; w.x = cvt_pk_bf16(o[0], o[1]); w.y = cvt_pk_bf16(o[2], o[3]);
        *(u32x2*)(out + (size_t)j * DM) = w;
        if (j < 31) S += XH(j + 2 * half) - XH(j); }
#undef XH
}
__device__ __forceinline__ void pool_local(int l, bf16_t* P, int pm, int pn) {
    const Params p = kparams();
    const int tid = opaque_tid(), lane = tid & 63, wave = __builtin_amdgcn_readfirstlane(tid >> 6);
    const int chunk = pm * 8 + wave, rowt = pm * 256, cond = rowt < NP ? 0 : 1 + ((rowt - NP) >> 11), col = pn * 256 + lane * 4;
    const float* mod = (const float*)(p.ws + WS_MOD) + ((size_t)l * 5 + cond) * NMODW;
    const f32x4 Av = *(const f32x4*)(p.norm_gains + (size_t)(l * 4) * DM + col) * (*(const f32x4*)(mod + DM + col) + 1.0f);
    const bf16_t* X16 = (const bf16_t*)(p.ws + WS_X16 + (l == 3 ? X16_COPY : 0)); const float* RS = (const float*)(p.ws + WS_RS);
    if (pn == 0) pool_item_x<0>(X16, RS, Av, P, chunk, lane); else if (pn == 1) pool_item_x<1>(X16, RS, Av, P, chunk, lane); else if (pn == 2) pool_item_x<2>(X16, RS, Av, P, chunk, lane); else pool_item_x<3>(X16, RS, Av, P, chunk, lane);
    asm volatile("s_waitcnt vmcnt(0)" ::: "memory");
    __builtin_amdgcn_fence(__ATOMIC_ACQUIRE, "agent");
    asm volatile("s_waitcnt vmcnt(0)" ::: "memory");
    __syncthreads();
}
__device__ __forceinline__ void pool_pass(const bf16_t* H, bf16_t* P) {
    const int tid = opaque_tid(), lane = tid & 63, wave = __builtin_amdgcn_readfirstlane(tid >> 6), gw = blockIdx.x * NWAVES + wave, NGW = gridDim.x * NWAVES;
    for (int it = gw; it < (NTOK / 32) * 4; it += NGW) { const int chunk = it >> 2, g = it & 3;
        if (g == 0) pool_item<0>(H, P, chunk, lane); else if (g == 1) pool_item<1>(H, P, chunk, lane); else if (g == 2) pool_item<2>(H, P, chunk, lane); else pool_item<3>(H, P, chunk, lane); }
}

__device__ __forceinline__ void attn_phase(char* lds, int G, int al) {
    const Params p = kparams();
    unsigned char* ws = p.ws;
    const bf16_t* qkv = (const bf16_t*)(ws + WS_QKV); const bf16_t* Kp = (const bf16_t*)(ws + WS_KP); const bf16_t* Ks = (const bf16_t*)(ws + WS_KS + (size_t)al * KVS_LAYER);
    const bf16_t* Vp = (const bf16_t*)(ws + WS_VP); const bf16_t* Vs = (const bf16_t*)(ws + WS_VS + (size_t)al * KVS_LAYER); bf16_t* AO = (bf16_t*)(ws + WS_ATTO);
#pragma unroll 1
    for (int u = vcu(); u < 512; u += G) {
        const bf16_t *Qb, *Kh, *Vh; bf16_t* Ob; int seq;
        if (u < 256) { const int combo = u & 7, b = combo >> 1, kvh = combo & 1, w = u >> 3, hq = kvh * 4 + (w >> 3), qb = w & 7;
            const size_t row0 = (size_t)NP + b * SEQ_S + qb * 256;
            Qb = qkv + row0 * DM + hq * 128; Kh = Ks + (size_t)b * KV_S * KVW + kvh * 128; Vh = Vs + (size_t)b * KV_S * KVW + kvh * 128; Ob = AO + row0 * DM + hq * 128; seq = KV_S; }
        else { const int u2 = u - 256, b = u2 >> 3, hq = u2 & 7, kvh = hq >> 2; const size_t row0 = (size_t)b * SEQ_P;
            Qb = qkv + row0 * DM + hq * 128; Kh = Kp + row0 * KVW + kvh * 128; Vh = Vp + row0 * KVW + kvh * 128; Ob = AO + row0 * DM + hq * 128; seq = SEQ_P; }
        attn::attn_dense_body(Qb, Kh, Vh, Ob, seq, lds);
        __syncthreads();
    }
}


#define XB_TMO      128
#define XB_XCNT(j)  (256  + 64 * (j))
#define XB_XSUB(j)  (1280 + 64 * (j))
#define XB_XGEN(j)  (2304 + 64 * (j))
#define XB_TOP      3328
#define XB_TOPGEN   3392
#define XCD_BAR_WORDS 3456
#define XB_SPIN_CAP (1u << 18)
__device__ __forceinline__ unsigned xb_ld(unsigned* p)              { return __hip_atomic_load(p, __ATOMIC_RELAXED, __HIP_MEMORY_SCOPE_AGENT); }
__device__ __forceinline__ unsigned xb_add(unsigned* p, unsigned v) { return __hip_atomic_fetch_add(p, v, __ATOMIC_RELAXED, __HIP_MEMORY_SCOPE_AGENT); }
__device__ __forceinline__ unsigned xb_xcc_id() { return (unsigned)__builtin_amdgcn_s_getreg((3 << 11) | 20) & 0xFu; }
#define XB_SPIN(cond, bar) do { unsigned _sp = 0; while (cond) { __builtin_amdgcn_s_sleep(1); \
    if ((++_sp & 255u) == 0u) { if (xb_ld(&(bar)[XB_TMO])) break; if (_sp > XB_SPIN_CAP) { atomicAdd(&(bar)[XB_TMO], 1u); break; } } } } while (0)
__device__ __forceinline__ void xcd_barrier_post(unsigned* bar, volatile LAS unsigned* misc) {
    if (opaque_tid() == 0) { const unsigned x = xb_xcc_id(); misc[16] = xb_add(&bar[XB_XCNT(x)], 1u); misc[17] = x; }
}
__device__ __forceinline__ void xcd_barrier_complete(unsigned* bar, unsigned x, unsigned& nloc, unsigned& nx) {
    const unsigned G = gridDim.x * gridDim.y * gridDim.z;
    unsigned sum, cnt, mine, sp = 0u;
    for (;;) {
        sum = 0u; cnt = 0u; mine = 0u;
#pragma unroll
        for (unsigned j = 0; j < 16; ++j) { const unsigned c = xb_ld(&bar[XB_XCNT(j)]); sum += c; cnt += (c > 0u) ? 1u : 0u; mine = (j == x) ? c : mine; }
        if (sum == G) break;
        __builtin_amdgcn_s_sleep(1);
        if ((++sp & 255u) == 0u) { if (xb_ld(&bar[XB_TMO])) break; if (sp > XB_SPIN_CAP) { atomicAdd(&bar[XB_TMO], 1u); break; } }
    }
    nloc = mine > 0u ? mine : 1u; nx = cnt > 0u ? cnt : 1u;
}
__device__ __forceinline__ bool xcd_census_uniform(unsigned* bar) {
    bool ok = (gridDim.x == 256);
#pragma unroll
    for (unsigned j = 0; j < 16; ++j) { const unsigned c = xb_ld(&bar[XB_XCNT(j)]); ok = ok && (j < 8u ? c == 32u : c == 0u); }
    return ok;
}
extern __shared__ __attribute__((aligned(16))) unsigned char lds_raw[];
constexpr int MISC_OFF = 147456 - 128;
__device__ __forceinline__ void xcd_barrier_now() {
    asm volatile("s_waitcnt vmcnt(0)" ::: "memory");
    __syncthreads();
    if (opaque_tid() == 0) {
        const Params kp = kparams();
        unsigned* bar = (unsigned*)kp.ws + CW_BAR; const unsigned x = xb_xcc_id();
        volatile LAS unsigned* st = (volatile LAS unsigned*)((LAS unsigned char*)lds_raw + MISC_OFF + 32);
        __builtin_amdgcn_s_waitcnt(0);
        unsigned nloc = st[0], nx = st[1];
        if (nloc == 0u) { xcd_barrier_complete(bar, x, nloc, nx); st[0] = nloc; st[1] = nx; st[10] = xcd_census_uniform(bar) ? 1u : 0u; }
        const unsigned old = xb_add(&bar[XB_XSUB(x)], 1u);
        const unsigned gen = old / nloc;
        if (old + 1u == (gen + 1u) * nloc) {
            __builtin_amdgcn_fence(__ATOMIC_RELEASE, "agent");
            asm volatile("s_waitcnt vmcnt(0)" ::: "memory");
            const unsigned og = xb_add(&bar[XB_TOP], 1u);
            const unsigned tg = og / nx;
            if (og + 1u == (tg + 1u) * nx) xb_add(&bar[XB_TOPGEN], 1u);
            else XB_SPIN(xb_ld(&bar[XB_TOPGEN]) == tg, bar);
            __builtin_amdgcn_fence(__ATOMIC_ACQUIRE, "agent");
            xb_add(&bar[XB_XGEN(x)], 1u);
            asm volatile("s_waitcnt vmcnt(0)" ::: "memory");
        } else {
            XB_SPIN(xb_ld(&bar[XB_XGEN(x)]) == gen, bar);
            __builtin_amdgcn_fence(__ATOMIC_ACQUIRE, "agent");
            asm volatile("s_waitcnt vmcnt(0)" ::: "memory");
        }
    }
    __syncthreads();
}


__device__ __forceinline__ bool census_uniform() { return ((volatile LAS unsigned*)((LAS unsigned char*)lds_raw + MISC_OFF))[18] != 0u; }
__device__ __forceinline__ int vcu() {
    volatile LAS unsigned* misc = (volatile LAS unsigned*)((LAS unsigned char*)lds_raw + MISC_OFF);
    const unsigned v = misc[18] != 0u ? misc[16] * 8u + misc[17] : blockIdx.x;
    return __builtin_amdgcn_readfirstlane((int)v);
}
__device__ __forceinline__ void xcc_barrier_now() {
    if (!census_uniform()) { xcd_barrier_now(); return; }
    asm volatile("s_waitcnt vmcnt(0)" ::: "memory");
    __syncthreads();
    if (opaque_tid() == 0) {
        const Params kp = kparams();
        unsigned* ctl = (unsigned*)kp.ws; unsigned* bar = ctl + CW_BAR; const unsigned x = xb_xcc_id();
        __builtin_amdgcn_s_waitcnt(0);
        const unsigned old = xb_add(&ctl[1024 + 64 * x], 1u);
        const unsigned gen = old / 32u;
        if (old + 1u == (gen + 1u) * 32u) xb_add(&ctl[2048 + 64 * x], 1u);
        else XB_SPIN(xb_ld(&ctl[2048 + 64 * x]) == gen, bar);
        __builtin_amdgcn_fence(__ATOMIC_ACQUIRE, "agent");
        asm volatile("s_waitcnt vmcnt(0)" ::: "memory");
    }
    __syncthreads();
}

__global__ void __launch_bounds__(NWAVES * 64, 2) mega_fwd(Params p_unused) {
    cg::grid_group grid = cg::this_grid();
    LAS unsigned char* lds = (LAS unsigned char*)lds_raw;
    const int G = gridDim.x;
    volatile LAS unsigned* MISC = (volatile LAS unsigned*)(lds + MISC_OFF);
    if (threadIdx.x < 32) MISC[threadIdx.x] = 0u;
    __syncthreads();
    { const Params p = kparams(); xcd_barrier_post((unsigned*)p.ws + CW_BAR, MISC); }

    { const Params p = kparams(); u32x4* z = (u32x4*)(p.ws + WS_XB1);
      for (int i = (int)blockIdx.x * (NWAVES * 64) + (int)threadIdx.x; i < (int)(2 * 524288 / 16); i += G * NWAVES * 64) z[i] = (u32x4){0u, 0u, 0u, 0u}; }
    mod_items(0, 192, (int)blockIdx.x, G, lds);
    if (gridDim.y == 12345u) grid.sync();
    xcd_barrier_now();
    { const Params p = kparams(); const float* mod = (const float*)(p.ws + WS_MOD);
      rowpass(p.x_prompt, p.x_sample, nullptr, nullptr, mod, 5, p.norm_gains, mod, 0, p.norm_gains, (bf16_t*)(p.ws + WS_H), (bf16_t*)(p.ws + WS_X16)); }
    prep_phase(lds);
    xcd_barrier_now();

    unsigned seq = 0;
#pragma unroll 1
    for (int l = 0; l < 4; ++l) {
        if ((l & 1) == 0) {
            const int al = l >> 1;
            { const Params p = kparams();
              pg8::Gemm g{(const bf16_t*)(p.ws + WS_H), (const bf16_t*)(p.ws + WS_WQKV) + (size_t)al * QKVW * DM, NTOK, QKVW, DM, DM, 0};
              pg8::StaticOrder S; S.init(NTOK, QKVW, G, vcu());
              pg8::EpiQKV E{al};
              pg8::gemm_phase<pg8::EpiQKV, pg8::StaticOrder, true>(lds, g, S, E);
            }
            if (l == 0) { const int R = (64 * 6) % G, nidle = R ? G - R : G, bi = R ? vcu() - R : vcu();
                if (bi >= 0) mod_items(192, 768, bi, nidle, lds); }
            xcd_barrier_now();
            attn_phase((char*)lds_raw, G, al);
            xcd_barrier_now();
        } else {
            const Params p = kparams();
            if (G == 256) { pg8::StaticOrder S; S.init(NTOK, DM, G, vcu()); pg8::Unit u; S.next(0, u);
                pool_local(l, (bf16_t*)(p.ws + WS_QKV), u.pm, u.pn); }
            else { pool_pass((const bf16_t*)(p.ws + WS_H), (bf16_t*)(p.ws + WS_QKV)); xcd_barrier_now(); }
        }
        { const Params p = kparams();
          pg8::Gemm gm;
          if ((l & 1) == 0) gm = pg8::Gemm{(const bf16_t*)(p.ws + WS_ATTO), (const bf16_t*)(p.ws + WS_WO) + (size_t)(l >> 1) * DM * DM, NTOK, DM, DM, DM, 0};
          else gm = pg8::Gemm{(const bf16_t*)(p.ws + WS_QKV), (const bf16_t*)(p.ws + WS_WPOOL) + (size_t)(l >> 1) * DM * 256, NTOK, DM, 256, DM, 256};
          pg8::StaticOrder S; S.init(NTOK, DM, G, vcu());
          pg8::EpiFused E{l, 0, 32u * (seq + 1u)}; ++seq;
          pg8::gemm_phase<pg8::EpiFused, pg8::StaticOrder, false>(lds, gm, S, E); }
        xcc_barrier_now();
        { const Params p = kparams();
          pg8::Gemm g{(const bf16_t*)(p.ws + WS_H), (const bf16_t*)(p.ws + WS_WUP) + (size_t)l * 2 * DFF * DM, NTOK, 2 * DFF, DM, DM, 0};
          pg8::StaticOrder S; S.init(NTOK, 2 * DFF, G, vcu());
          pg8::EpiSwiGLU E{(bf16_t*)(p.ws + WS_ACT)};
          pg8::gemm_phase<pg8::EpiSwiGLU, pg8::StaticOrder, true>(lds, g, S, E);
        }
        if (l < 3) { const int R = (64 * 22) % G, nidle = R ? G - R : G; const int bi = R ? vcu() - R : vcu();
            if (bi >= 0) convert_layer_weights(l + 1, bi * NWAVES + __builtin_amdgcn_readfirstlane(opaque_tid() >> 6), nidle * NWAVES, lds); }
        if (l < 3) xcd_barrier_now();
        else xcc_barrier_now();
        { const Params p = kparams();
          pg8::Gemm g{(const bf16_t*)(p.ws + WS_ACT), (const bf16_t*)(p.ws + WS_WDN) + (size_t)l * DM * DFF, NTOK, DM, DFF, DFF, 0};
          pg8::StaticOrder S; S.init(NTOK, DM, G, vcu());
          pg8::EpiFused E{l, 1, 32u * (seq + 1u)}; ++seq;
          pg8::gemm_phase<pg8::EpiFused, pg8::StaticOrder, false>(lds, g, S, E); }
        if (l < 3) xcc_barrier_now();
    }
}

extern "C" void kernel_launch(void* const* d_in, const int* in_sizes, int n_in, void* d_out, int out_size, void* d_ws, size_t ws_size, hipStream_t stream) {
    static int grid = 0;
    if (grid == 0) {
        if (n_in != 16 || ws_size < WS_END) { fprintf(stderr, "kernel_launch: unexpected n_in %d / ws_size %zu (need %zu)\n", n_in, ws_size, (size_t)WS_END); grid = -1; return; }
        int dev = 0, cus = 0, per_cu = 0;
        if (hipGetDevice(&dev) != hipSuccess || hipDeviceGetAttribute(&cus, hipDeviceAttributeMultiprocessorCount, dev) != hipSuccess) { grid = -1; return; }
        if (hipFuncSetAttribute((const void*)mega_fwd, hipFuncAttributeMaxDynamicSharedMemorySize, LDS_BYTES) != hipSuccess) { fprintf(stderr, "kernel_launch: hipFuncSetAttribute failed\n"); grid = -1; return; }
        if (hipOccupancyMaxActiveBlocksPerMultiprocessor(&per_cu, (const void*)mega_fwd, NWAVES * 64, LDS_BYTES) != hipSuccess || per_cu < 1) { fprintf(stderr, "kernel_launch: occupancy query says %d\n", per_cu); per_cu = 1; }
        (void)hipGetLastError();
        grid = cus;
    }
    if (grid < 0) return;
    if (hipMemsetAsync(d_ws, 0, CTL_ZERO_BYTES, stream) != hipSuccess) { fprintf(stderr, "kernel_launch: memset failed\n"); return; }
    Params p{};
    p.x_prompt = (const float*)d_in[0]; p.x_sample = (const float*)d_in[1]; p.c = (const float*)d_in[2]; p.cache_k = (const float*)d_in[3]; p.cache_v = (const float*)d_in[4];
    p.c_ctx = (const float*)d_in[5]; p.w_ada = (const float*)d_in[6]; p.b_ada = (const float*)d_in[7]; p.norm_gains = (const float*)d_in[8]; p.w_qkv = (const float*)d_in[9];
    p.qk_gains = (const float*)d_in[10]; p.w_o = (const float*)d_in[11]; p.w_pool = (const float*)d_in[12]; p.pool_scale = (const float*)d_in[13]; p.w_up = (const float*)d_in[14]; p.w_down = (const float*)d_in[15];
    p.out = (float*)d_out; p.ws = (unsigned char*)d_ws;
    void* args[] = {&p};
    const hipError_t e = hipLaunchCooperativeKernel((const void*)mega_fwd, dim3(grid), dim3(NWAVES * 64), args, LDS_BYTES, stream);
    if (e != hipSuccess) fprintf(stderr, "kernel_launch: cooperative launch failed: %s (grid %d)\n", hipGetErrorString(e), grid);
}
```
